# Optimizing an MI355X kernel written in HIP

```python
import math
import jax, jax.numpy as jnp
from jax import lax
import numpy as np

D_MODEL = 2048
BATCH = 8
SEQ = 2048
DEPTH = 1

ATTN_HEAD_DIM = 64
ATTN_HEADS = (D_MODEL // 2) // ATTN_HEAD_DIM
ATTN_KV_HEADS = 4
WINDOW = 128
ATTN_BLOCK = 128
DN_HEAD_DIM = 128
DN_HEADS = (D_MODEL // 2) // DN_HEAD_DIM
DN_CHUNK = 64
CONV_WIDTH = 4

ATTN_Q_W = ATTN_HEADS * ATTN_HEAD_DIM
ATTN_KV_W = ATTN_KV_HEADS * ATTN_HEAD_DIM
DN_W = DN_HEADS * DN_HEAD_DIM
MIX_WIDTH = ATTN_Q_W + DN_W
IN_WIDTHS = (ATTN_Q_W, ATTN_KV_W, ATTN_KV_W, DN_W, DN_W, DN_W, DN_W, DN_HEADS, DN_HEADS)
IN_WIDTH = sum(IN_WIDTHS)

N_EXPERTS = 32
TOP_K = 4
D_EXPERT = D_MODEL
SWIGLU_ALPHA = 1.702
SWIGLU_LIMIT = 7.0
MOE_BLOCK = 256

NORM_EPS = 1e-5
QK_NORM_EPS = 1e-6
DN_NORM_EPS = 1e-6
L2_EPS = 1e-6

kernel_name = "hybrid_swa_sink_gdn_moe_layer"


def rms_norm(x, w, eps):
    xf = x.astype(jnp.float32)
    y = xf * lax.rsqrt(jnp.mean(xf * xf, axis=-1, keepdims=True) + eps)
    return (y * w.astype(jnp.float32)).astype(x.dtype)


def l2_normalize(x):
    return x * lax.rsqrt(jnp.sum(x * x, axis=-1, keepdims=True) + L2_EPS)


def alibi_slopes(n):
    return 2.0 ** (-8.0 * jnp.arange(1, n + 1, dtype=jnp.float32) / n)


def sliding_window_attention(q, k, v, sinks):
    B, S = q.shape[0], q.shape[1]
    L = ATTN_BLOCK
    nb = S // L
    G = ATTN_HEADS // ATTN_KV_HEADS
    qb = q.reshape(B, nb, L, ATTN_KV_HEADS, G, ATTN_HEAD_DIM)
    pad = ((0, 0), (L, 0), (0, 0), (0, 0))
    kp = jnp.pad(k, pad).reshape(B, nb + 1, L, ATTN_KV_HEADS, ATTN_HEAD_DIM)
    vp = jnp.pad(v, pad).reshape(B, nb + 1, L, ATTN_KV_HEADS, ATTN_HEAD_DIM)
    kw = jnp.concatenate([kp[:, :-1], kp[:, 1:]], axis=2)
    vw = jnp.concatenate([vp[:, :-1], vp[:, 1:]], axis=2)
    scores = jnp.einsum('bnqhgd,bnkhd->bnhgqk', qb, kw,
                        preferred_element_type=jnp.float32) * (ATTN_HEAD_DIM ** -0.5)
    q_pos = jnp.arange(S, dtype=jnp.int32).reshape(nb, L)
    k_pos = jnp.arange(-L, S, dtype=jnp.int32).reshape(nb + 1, L)
    k_win = jnp.concatenate([k_pos[:-1], k_pos[1:]], axis=1)
    dist = q_pos[:, :, None] - k_win[:, None, :]
    valid = (dist >= 0) & (dist < WINDOW) & (k_win[:, None, :] >= 0)
    slopes = alibi_slopes(ATTN_HEADS).reshape(ATTN_KV_HEADS, G)
    bias = -slopes[None, None, :, :, None, None] * dist.astype(jnp.float32)[None, :, None, None]
    scores = jnp.where(valid[None, :, None, None], scores + bias, -jnp.inf)
    sink = sinks.astype(jnp.float32).reshape(ATTN_KV_HEADS, G)[None, None, :, :, None, None]
    m = jnp.maximum(jnp.max(scores, axis=-1, keepdims=True), sink)
    p = jnp.exp(scores - m)
    denom = jnp.sum(p, axis=-1, keepdims=True) + jnp.exp(sink - m)
    probs = (p / denom).astype(v.dtype)
    out = jnp.einsum('bnhgqk,bnkhd->bnqhgd', probs, vw)
    return out.reshape(B, S, ATTN_Q_W)


def causal_depthwise_conv(x, w):
    K, C = w.shape
    return lax.conv_general_dilated(x, w[:, None, :], window_strides=(1,),
                                    padding=[(K - 1, 0)],
                                    dimension_numbers=('NWC', 'WIO', 'NWC'),
                                    feature_group_count=C)


def chunked_gated_delta_rule(q, k, v, g, beta):
    B, H, S, dk = q.shape
    dv = v.shape[-1]
    C = DN_CHUNK
    n = S // C
    q = q * (dk ** -0.5)
    qc = q.reshape(B, H, n, C, dk)
    kc = k.reshape(B, H, n, C, dk)
    vc = v.reshape(B, H, n, C, dv)
    bc = beta.reshape(B, H, n, C)
    gc = jnp.cumsum(g.reshape(B, H, n, C), axis=-1)
    tril = jnp.tril(jnp.ones((C, C), dtype=bool))
    strict = jnp.tril(jnp.ones((C, C), dtype=bool), -1)
    decay = jnp.exp(jnp.where(tril, gc[..., :, None] - gc[..., None, :], -jnp.inf))
    k_beta = kc * bc[..., None]
    v_beta = vc * bc[..., None]
    lower = jnp.where(strict, jnp.einsum('bhncd,bhnsd->bhncs', k_beta, kc) * decay, 0.0)
    a_mat = lower + jnp.eye(C, dtype=jnp.float32)
    rhs = jnp.concatenate([v_beta, k_beta * jnp.exp(gc)[..., None]], axis=-1)
    sol = lax.linalg.triangular_solve(a_mat, rhs, left_side=True, lower=True, unit_diagonal=True)
    u = sol[..., :dv]
    w = sol[..., dv:]
    attn_intra = jnp.where(tril, jnp.einsum('bhncd,bhnsd->bhncs', qc, kc) * decay, 0.0)

    def step(state, xs):
        q_i, k_i, u_i, w_i, g_i, a_i = xs
        v_new = u_i - jnp.matmul(w_i, state)
        o_i = jnp.matmul(q_i * jnp.exp(g_i)[..., None], state) + jnp.matmul(a_i, v_new)
        g_last = g_i[..., -1]
        k_dec = k_i * jnp.exp(g_last[..., None] - g_i)[..., None]
        state = state * jnp.exp(g_last)[..., None, None] + jnp.einsum('bhcd,bhce->bhde', k_dec, v_new)
        return state, o_i

    xs = tuple(jnp.moveaxis(t, 2, 0) for t in (qc, kc, u, w, gc, attn_intra))
    state0 = jnp.zeros((B, H, dk, dv), jnp.float32)
    _, o = lax.scan(step, state0, xs)
    return jnp.moveaxis(o, 0, 2).reshape(B, H, S, dv)


def gated_deltanet(dq, dk, dv, dz, db, da, conv_w, a_log, dt_bias, norm_w):
    B, S = dq.shape[0], dq.shape[1]
    qkv = jax.nn.silu(causal_depthwise_conv(jnp.concatenate([dq, dk, dv], axis=-1), conv_w))
    q, k, v = jnp.split(qkv.astype(jnp.float32), 3, axis=-1)
    heads = lambda t: t.reshape(B, S, DN_HEADS, DN_HEAD_DIM).transpose(0, 2, 1, 3)
    q = l2_normalize(heads(q))
    k = l2_normalize(heads(k))
    v = heads(v)
    beta = jax.nn.sigmoid(db.astype(jnp.float32)).transpose(0, 2, 1)
    g = (-jnp.exp(a_log.astype(jnp.float32))
         * jax.nn.softplus(da.astype(jnp.float32) + dt_bias.astype(jnp.float32))).transpose(0, 2, 1)
    o = chunked_gated_delta_rule(q, k, v, g, beta).transpose(0, 2, 1, 3)
    z = dz.astype(jnp.float32).reshape(B, S, DN_HEADS, DN_HEAD_DIM)
    o = rms_norm(o, norm_w, DN_NORM_EPS) * jax.nn.silu(z)
    return o.reshape(B, S, DN_W).astype(dq.dtype)


def moe_ffn(x, w_router, b_router, w_gate_up, b_gate_up, w_down, b_down):
    B, S, D = x.shape
    T = B * S
    xf = x.reshape(T, D)
    logits = jnp.matmul(xf, w_router).astype(jnp.float32) + b_router.astype(jnp.float32)
    top_vals, top_idx = lax.top_k(logits, TOP_K)
    gates = jax.nn.softmax(top_vals, axis=-1)
    n_assign = T * TOP_K
    e_flat = top_idx.reshape(n_assign)
    tok_flat = jnp.repeat(jnp.arange(T, dtype=jnp.int32), TOP_K)
    g_flat = gates.reshape(n_assign)
    order = jnp.argsort(e_flat)
    e_sorted = e_flat[order]
    counts = jnp.bincount(e_flat, length=N_EXPERTS)
    padded = (counts + MOE_BLOCK - 1) // MOE_BLOCK * MOE_BLOCK
    starts = jnp.cumsum(counts) - counts
    ends_p = jnp.cumsum(padded)
    pstarts = ends_p - padded
    dest = pstarts[e_sorted] + (jnp.arange(n_assign, dtype=jnp.int32) - starts[e_sorted])
    n_blocks = -(-n_assign // MOE_BLOCK) + N_EXPERTS
    P = n_blocks * MOE_BLOCK
    row_tok = jnp.full((P,), T, jnp.int32).at[dest].set(tok_flat[order])
    row_gate = jnp.zeros((P,), jnp.float32).at[dest].set(g_flat[order])
    block_expert = jnp.minimum(
        jnp.searchsorted(ends_p, jnp.arange(n_blocks, dtype=jnp.int32) * MOE_BLOCK, side='right'),
        N_EXPERTS - 1)
    x_pad = jnp.concatenate([xf, jnp.zeros((1, D), xf.dtype)], axis=0)

    def expert_block(args):
        e, toks, gts = args
        h = jnp.matmul(x_pad[toks], w_gate_up[e]) + b_gate_up[e]
        h_glu, h_lin = jnp.split(h, 2, axis=-1)
        h_glu = jnp.minimum(h_glu, SWIGLU_LIMIT)
        h_lin = jnp.clip(h_lin, -SWIGLU_LIMIT, SWIGLU_LIMIT)
        act = h_glu * jax.nn.sigmoid(SWIGLU_ALPHA * h_glu) * (h_lin + 1.0)
        y = jnp.matmul(act, w_down[e]) + b_down[e]
        return y.astype(jnp.float32) * gts[:, None]

    y = lax.map(expert_block, (block_expert, row_tok.reshape(n_blocks, MOE_BLOCK),
                               row_gate.reshape(n_blocks, MOE_BLOCK)))
    out = jnp.zeros((T + 1, D), jnp.float32).at[row_tok].add(y.reshape(P, D))[:T]
    return out.reshape(B, S, D).astype(x.dtype)


def setup_inputs(seed: int = 0) -> dict:
    key = jax.random.key(seed)
    ks = jax.random.split(key, 18)
    f32 = jnp.float32
    nrm = lambda k, shape, s: jax.random.normal(k, shape, f32) * s
    return {
        "x": nrm(ks[0], (BATCH, SEQ, D_MODEL), 1.0),
        "attn_norm_w": 1.0 + nrm(ks[1], (DEPTH, D_MODEL), 0.02),
        "w_in": nrm(ks[2], (DEPTH, D_MODEL, IN_WIDTH), D_MODEL ** -0.5),
        "q_norm_w": 1.0 + nrm(ks[3], (DEPTH, ATTN_HEAD_DIM), 0.02),
        "k_norm_w": 1.0 + nrm(ks[4], (DEPTH, ATTN_HEAD_DIM), 0.02),
        "attn_sinks": nrm(ks[5], (DEPTH, ATTN_HEADS), 0.5),
        "conv_w": nrm(ks[6], (DEPTH, CONV_WIDTH, 3 * DN_W), CONV_WIDTH ** -0.5),
        "a_log": jnp.log(jax.random.uniform(ks[7], (DEPTH, DN_HEADS), f32, 1.0, 16.0)),
        "dt_bias": 1.0 + nrm(ks[8], (DEPTH, DN_HEADS), 0.1),
        "dn_norm_w": 1.0 + nrm(ks[9], (DEPTH, DN_HEAD_DIM), 0.02),
        "w_out": nrm(ks[10], (DEPTH, MIX_WIDTH, D_MODEL), MIX_WIDTH ** -0.5),
        "ffn_norm_w": 1.0 + nrm(ks[11], (DEPTH, D_MODEL), 0.02),
        "w_router": nrm(ks[12], (DEPTH, D_MODEL, N_EXPERTS), D_MODEL ** -0.5),
        "b_router": nrm(ks[13], (DEPTH, N_EXPERTS), 0.01),
        "w_gate_up": nrm(ks[14], (DEPTH, N_EXPERTS, D_MODEL, 2 * D_EXPERT), D_MODEL ** -0.5),
        "b_gate_up": nrm(ks[15], (DEPTH, N_EXPERTS, 2 * D_EXPERT), 0.01),
        "w_down": nrm(ks[16], (DEPTH, N_EXPERTS, D_EXPERT, D_MODEL), D_EXPERT ** -0.5),
        "b_down": nrm(ks[17], (DEPTH, N_EXPERTS, D_MODEL), 0.01),
    }


def reference(x, attn_norm_w, w_in, q_norm_w, k_norm_w, attn_sinks, conv_w, a_log, dt_bias,
              dn_norm_w, w_out, ffn_norm_w, w_router, b_router, w_gate_up, b_gate_up,
              w_down, b_down):
    B, S = x.shape[0], x.shape[1]
    split_points = [int(p) for p in np.cumsum(IN_WIDTHS)[:-1]]
    h = x
    for l in range(DEPTH):
        u = rms_norm(h, attn_norm_w[l], NORM_EPS)
        proj = jnp.matmul(u, w_in[l])
        aq, ak, av, dq, dk, dv, dz, db, da = jnp.split(proj, split_points, axis=-1)
        aq = rms_norm(aq.reshape(B, S, ATTN_HEADS, ATTN_HEAD_DIM), q_norm_w[l], QK_NORM_EPS)
        ak = rms_norm(ak.reshape(B, S, ATTN_KV_HEADS, ATTN_HEAD_DIM), k_norm_w[l], QK_NORM_EPS)
        av = av.reshape(B, S, ATTN_KV_HEADS, ATTN_HEAD_DIM)
        attn_out = sliding_window_attention(aq, ak, av, attn_sinks[l])
        dn_out = gated_deltanet(dq, dk, dv, dz, db, da, conv_w[l], a_log[l], dt_bias[l],
                                dn_norm_w[l])
        mixed = jnp.concatenate([attn_out, dn_out.astype(attn_out.dtype)], axis=-1)
        h = h + jnp.matmul(mixed, w_out[l]).astype(h.dtype)
        u = rms_norm(h, ffn_norm_w[l], NORM_EPS)
        h = h + moe_ffn(u, w_router[l], b_router[l], w_gate_up[l], b_gate_up[l],
                        w_down[l], b_down[l])
    return h
```

```cpp
#include <hip/hip_runtime.h>
#include <cstdio>
#include <cstdint>

constexpr int BATCH = 8, SEQ = 2048, T = BATCH * SEQ, D = 2048;
constexpr int INW = 5648, INP = 5888, PROJW = 5632;
constexpr int C_AQ = 0, C_AK = 1024, C_AV = 1280, C_DQ = 1536, C_DK = 2560, C_DV = 3584, C_DZ = 4608;
constexpr int NE = 32, TOPK = 4, FF = 2048;
constexpr int NASSIGN = T * TOPK;
constexpr int MAXBLK = NASSIGN / 256 + NE;
constexpr int P = MAXBLK * 256;

typedef unsigned short bf16_t;
typedef short bf16x8 __attribute__((ext_vector_type(8)));
typedef float f32x4 __attribute__((ext_vector_type(4)));
typedef unsigned u32x4 __attribute__((ext_vector_type(4)));
typedef unsigned u32x2 __attribute__((ext_vector_type(2)));
typedef int v4i_t __attribute__((ext_vector_type(4)));
typedef int v8i_t __attribute__((ext_vector_type(8)));

constexpr size_t al256(size_t x) { return (x + 255) & ~(size_t)255; }
constexpr size_t WS_CTL = 0, CTL_BYTES = 1u << 20;
constexpr size_t WS_WINT = WS_CTL + CTL_BYTES;
constexpr size_t WS_WOUTT = WS_WINT + al256((size_t)INP * D * 2);
constexpr size_t WS_WGUT = WS_WOUTT + al256((size_t)D * D * 2);
constexpr size_t WS_WDT = WS_WGUT + al256((size_t)NE * 4096 * D * 2);
constexpr size_t WS_XN = WS_WDT + al256((size_t)NE * D * FF * 2);
constexpr size_t WS_PROJ = WS_XN + al256((size_t)T * D * 2);
constexpr size_t WS_BETA = WS_PROJ + al256((size_t)T * PROJW * 2);
constexpr size_t WS_GDEC = WS_BETA + al256((size_t)T * 8 * 4);
constexpr size_t WS_MIXED = WS_GDEC + al256((size_t)T * 8 * 4);
constexpr size_t WS_H = WS_MIXED + al256((size_t)T * D * 2);
constexpr size_t WS_U = WS_H + al256((size_t)T * D * 4);
constexpr size_t WS_TOPI = WS_U + al256((size_t)(T + 1) * D * 2);
constexpr size_t WS_GATE = WS_TOPI + al256((size_t)T * 4 * 4);
constexpr size_t WS_DEST = WS_GATE + al256((size_t)T * 4 * 4);
constexpr size_t WS_ROWTOK = WS_DEST + al256((size_t)T * 4 * 4);
constexpr size_t WS_XG = WS_ROWTOK + al256((size_t)P * 4);
constexpr size_t WS_ACT = WS_XG + al256((size_t)P * D * 2);
constexpr size_t WS_Y = WS_ACT + al256((size_t)P * FF * 2);
constexpr size_t WS_QN = WS_Y + al256((size_t)P * D * 2);
constexpr size_t WS_KN = WS_QN + al256((size_t)T * 1024 * 4);
constexpr size_t WS_NEGW = WS_KN + al256((size_t)T * 256 * 4);
constexpr size_t WS_QG = WS_NEGW + (size_t)2048 * 8192 * 2;
constexpr size_t WS_KDT = WS_QG + (size_t)2048 * 8192 * 2;
constexpr size_t WS_UT = WS_KDT + (size_t)2048 * 8192 * 2;
constexpr size_t WS_AM = WS_UT + (size_t)2048 * 8192 * 2;
constexpr size_t WS_GLAST = WS_AM + (size_t)2048 * 4096 * 2;
constexpr size_t WS_WB = WS_GLAST + al256(2048 * 4);
constexpr size_t WS_RSTD = WS_WB + (size_t)D * NE * 4;
constexpr size_t WS_LRANK = WS_RSTD + al256((size_t)(T + 1) * 4);
constexpr size_t WS_CNT = WS_LRANK + al256((size_t)T * 4 * 4);
constexpr size_t WS_RTOK = WS_CNT + al256(256 * 32 * 4);
constexpr size_t WS_XS = WS_RTOK + al256((size_t)P * 4);
constexpr size_t WS_WSC = WS_XS + al256((size_t)T * 4);
constexpr size_t WS_END = WS_WSC + al256(INP * 4);
constexpr int CW_COUNT = 8192;
constexpr int CW_CURSOR = 8192 + 64;
constexpr int CW_PSTART = 8192 + 128;
constexpr int CW_NBLK = 8192 + 192;
constexpr int CW_BLKE = 8192 + 256;
constexpr int CW_TILEQ = 16384;

__device__ __forceinline__ bf16_t f2bf(float f) { unsigned u = __float_as_uint(f); u += 0x7FFFu + ((u >> 16) & 1u); return (bf16_t)(u >> 16); }
__device__ __forceinline__ float bf2f(bf16_t b) { return __uint_as_float(((unsigned)b) << 16); }
__device__ __forceinline__ unsigned pk2(float lo, float hi) { return (unsigned)f2bf(lo) | ((unsigned)f2bf(hi) << 16); }
__device__ __forceinline__ float wave_sum(float v) {
#pragma unroll
    for (int o = 1; o < 64; o <<= 1) v += __shfl_xor(v, o);
    return v;
}
constexpr float U_SCALE = 16.0f, W_SCALE = 64.0f, ACT_SCALE = 8.0f, Y_SCALE = 16.0f;
__device__ __forceinline__ float clamp448(float x) { return fminf(fmaxf(x, -448.0f), 448.0f); }
__device__ __forceinline__ unsigned pk4_fp8(float a, float b, float c, float d) {
    int w = __builtin_amdgcn_cvt_pk_fp8_f32(clamp448(a), clamp448(b), 0, false); w = __builtin_amdgcn_cvt_pk_fp8_f32(clamp448(c), clamp448(d), w, true); return (unsigned)w; }
__device__ __forceinline__ int tid_opaque() { int t = (int)threadIdx.x; asm volatile("" : "+v"(t)); return t; }
__device__ __forceinline__ float sigmoidf_(float x) { return __builtin_amdgcn_rcpf(1.0f + __builtin_amdgcn_exp2f(-1.4426950408889634f * x)); }
__device__ __forceinline__ float siluf_(float x) { return x * __builtin_amdgcn_rcpf(1.0f + __builtin_amdgcn_exp2f(-1.4426950408889634f * x)); }
__device__ __forceinline__ float softplusf_(float x) { return x > 20.f ? x : log1pf(__expf(x)); }

namespace pg8 {
#define PG8_LAS __attribute__((address_space(3)))
constexpr int BM = 256, BK = 64, HALF = 128, HTB = HALF * BK * 2, STAGE_BYTES = 8 * HTB, NXCD = 8, WGM = 8;
__host__ __device__ __forceinline__ int lds_byte(int r, int c) { const int st = (r >> 4) * 2 + (c >> 5), rr = r & 15, cc = c & 31, ob = rr * 64 + cc * 2; return st * 1024 + (ob ^ (((ob >> 9) & 1) << 5)); }
__host__ __device__ __forceinline__ void stage_rc(int b, int& R, int& C) { const int st = b / 1024, sb = b % 1024, swz = sb ^ (((sb >> 9) & 1) << 5); R = (st >> 1) * 16 + swz / 64; C = (st & 1) * 32 + (swz % 64) / 2; }
__host__ __device__ __forceinline__ int perm32(int rho) { const int n = rho >> 4, i = rho & 15; return 8 * (i >> 2) + 4 * n + (i & 3); }

struct Unit { int pm, pn, pe; };
struct Gemm { const void* A; const void* Bt; size_t bstride; int K; int pad; };

struct StaticOrder {
    int nM, nN, nwg, G, c;
    __device__ void init(int nM_, int nN_, int G_, int c_) { nM = nM_; nN = nN_; nwg = nM * nN; G = G_; c = c_; }
    __device__ bool next(int i, Unit& u) const {
        const long L = (long)i * G + c; if (L >= nwg) return false;
        int wgid = (int)L; { const int q = nwg / NXCD, r = nwg % NXCD, xcd = wgid % NXCD, off = wgid / NXCD; wgid = (xcd < r ? xcd * (q + 1) : r * (q + 1) + (xcd - r) * q) + off; }
        const int nig = WGM * nN, gid = wgid / nig, fm = gid * WGM, gsz = (nM - fm) < WGM ? (nM - fm) : WGM;
        u.pm = fm + ((wgid % nig) % gsz); u.pn = (wgid % nig) / gsz; u.pe = 0; return true;
    }
};
struct MoeOrder : StaticOrder {
    const int* blke; const int* rowtok;
    __device__ bool next(int i, Unit& u) const { if (!StaticOrder::next(i, u)) return false; u.pe = __hip_atomic_load(blke + u.pm, __ATOMIC_RELAXED, __HIP_MEMORY_SCOPE_AGENT); return true; }
};

typedef __bf16 bf16v2_t __attribute__((ext_vector_type(2)));
typedef float f32v2_t __attribute__((ext_vector_type(2)));
__device__ __forceinline__ unsigned cvt_pk_bf16(float lo, float hi) { const f32v2_t v = {lo, hi}; return __builtin_bit_cast(unsigned, __builtin_convertvector(v, bf16v2_t)); }

template <class Epi, class Sched, bool ALIGN_EPI = true, bool FP8 = false, bool I8 = false, bool GATHER = false>
__device__ __forceinline__ void gemm_phase(PG8_LAS unsigned char* lds, const Gemm g, const Sched& S, const Epi& E) {
    const int tid = tid_opaque(), wid = __builtin_amdgcn_readfirstlane(tid >> 6), lane = tid & 63, wr = wid >> 2, wc = wid & 3, fr = lane & 15, fq = lane >> 4;
    const int pitch = (FP8 || I8) ? g.K : 2 * g.K, nt = pitch / 128;
#define PG8_G(r) (((((r) >> 1) & 7)) ^ (((((r) >> 1) & 7) & 2) << 1))
    unsigned voffA[2], voffB[2];
#pragma unroll
    for (int i = 0; i < 2; ++i) { const int o = tid * 16 + i * 8192, R = o >> 7, cp = (o >> 4) & 7, CB = (cp ^ PG8_G(R & 15)) * 16;
        const int Rb = Epi::PERM ? ((R & ~31) + perm32(R & 31)) : R;
        voffA[i] = (unsigned)(R * pitch + CB); voffB[i] = (unsigned)(Rb * pitch + CB); }
    const size_t kstep = (size_t)128;
    const size_t hstep = (size_t)HALF * pitch;
    const size_t tstep = 2 * hstep;
    const unsigned ldsw = (unsigned)wid * 1024u;
    const int c0 = FP8 ? 2 * fq : fq, c1 = FP8 ? 2 * fq + 1 : 4 + fq, gf = PG8_G(fr);
    unsigned ldsA0_u = (unsigned)(size_t)lds + (unsigned)((wr * 64 + fr) * 128 + ((c0 ^ gf) * 16)), ldsA1_u = (unsigned)(size_t)lds + (unsigned)((wr * 64 + fr) * 128 + ((c1 ^ gf) * 16));
    unsigned ldsB0_u = (unsigned)(size_t)lds + 65536u + (unsigned)((wc * 32 + fr) * 128 + ((c0 ^ gf) * 16)), ldsB1_u = (unsigned)(size_t)lds + 65536u + (unsigned)((wc * 32 + fr) * 128 + ((c1 ^ gf) * 16));
    asm volatile("" : "+v"(ldsA0_u), "+v"(ldsA1_u), "+v"(ldsB0_u), "+v"(ldsB1_u));
    const PG8_LAS unsigned char* ldsA0 = (const PG8_LAS unsigned char*)(size_t)ldsA0_u; const PG8_LAS unsigned char* ldsA1 = (const PG8_LAS unsigned char*)(size_t)ldsA1_u;
    const PG8_LAS unsigned char* ldsB0 = (const PG8_LAS unsigned char*)(size_t)ldsB0_u; const PG8_LAS unsigned char* ldsB1 = (const PG8_LAS unsigned char*)(size_t)ldsB1_u;
#undef PG8_G
#define PG8_SA(b, h) (((b) * 2 + (h)) * HTB)
#define PG8_SB(b, h) ((4 + (b) * 2 + (h)) * HTB)
#define PG8_STAGE(bufoff, gbase, voff) do { _Pragma("unroll") for (int _i = 0; _i < 2; ++_i) \
        __builtin_amdgcn_global_load_lds((const unsigned*)((const char*)(gbase) + (voff)[_i]), (PG8_LAS unsigned*)(lds + (bufoff) + ldsw + _i * 8192), 16, 0, 0); } while (0)
#define PG8_LD8(p0, p1, base) __builtin_shufflevector(*(const PG8_LAS v4i_t*)((p0) + (base)), *(const PG8_LAS v4i_t*)((p1) + (base)), 0, 1, 2, 3, 4, 5, 6, 7)
#define PG8_LDA(dst, b, h) do { if constexpr (FP8) { _Pragma("unroll") for (int m = 0; m < 4; ++m) dst##8[m] = PG8_LD8(ldsA0, ldsA1, PG8_SA(b, h) + m * 2048); } \
        else { _Pragma("unroll") for (int m = 0; m < 4; ++m) { dst[m][0] = *(const PG8_LAS bf16x8*)(ldsA0 + PG8_SA(b, h) + m * 2048); dst[m][1] = *(const PG8_LAS bf16x8*)(ldsA1 + PG8_SA(b, h) + m * 2048); } } } while (0)
#define PG8_LDB(dst, b, h) do { if constexpr (FP8) { _Pragma("unroll") for (int n = 0; n < 2; ++n) dst##8[n] = PG8_LD8(ldsB0, ldsB1, PG8_SB(b, h) - 65536 + n * 2048); } \
        else { _Pragma("unroll") for (int n = 0; n < 2; ++n) { dst[n][0] = *(const PG8_LAS bf16x8*)(ldsB0 + PG8_SB(b, h) - 65536 + n * 2048); dst[n][1] = *(const PG8_LAS bf16x8*)(ldsB1 + PG8_SB(b, h) - 65536 + n * 2048); } } } while (0)
#define PG8_MMA(ai, bj, At, Bt) do { __builtin_amdgcn_s_setprio(1); \
        if constexpr (FP8) { _Pragma("unroll") for (int m = 0; m < 4; ++m) _Pragma("unroll") for (int n = 0; n < 2; ++n) \
            asm volatile("v_mfma_scale_f32_16x16x128_f8f6f4 %0, %1, %2, %0, %3, %3 op_sel_hi:[0,0,0]" : "+v"(acc[ai][bj][m][n]) : "v"(Bt##8[n]), "v"(At##8[m]), "v"(one_scale)); } \
        else if constexpr (I8) { _Pragma("unroll") for (int m = 0; m < 4; ++m) _Pragma("unroll") for (int n = 0; n < 2; ++n) _Pragma("unroll") for (int k = 0; k < 2; ++k) \
            acc[ai][bj][m][n] = __builtin_bit_cast(f32x4, __builtin_amdgcn_mfma_i32_16x16x64_i8(__builtin_bit_cast(v4i_t, Bt[n][k]), __builtin_bit_cast(v4i_t, At[m][k]), __builtin_bit_cast(v4i_t, acc[ai][bj][m][n]), 0, 0, 0)); } \
        else { _Pragma("unroll") for (int m = 0; m < 4; ++m) _Pragma("unroll") for (int n = 0; n < 2; ++n) _Pragma("unroll") for (int k = 0; k < 2; ++k) \
            acc[ai][bj][m][n] = __builtin_amdgcn_mfma_f32_16x16x32_bf16(Bt[n][k], At[m][k], acc[ai][bj][m][n], 0, 0, 0); } \
        __builtin_amdgcn_s_setprio(0); } while (0)
#define PG8_WAIT_V(n) asm volatile("s_waitcnt vmcnt(" #n ")" ::: "memory")
#define PG8_WAIT_L(n) asm volatile("s_waitcnt lgkmcnt(" #n ")" ::: "memory")
#define PG8_BAR __builtin_amdgcn_s_barrier()
#define PG8_SCHED __builtin_amdgcn_sched_barrier(0)
    const int one_scale = 0x7F7F7F7F;
    Unit cur, nxt; int ui = 0;
    if (!S.next(0, cur)) return;
    f32x4 acc[2][2][4][2];
#pragma unroll
    for (int a = 0; a < 2; ++a)
#pragma unroll
        for (int b = 0; b < 2; ++b)
#pragma unroll
            for (int m = 0; m < 4; ++m)
#pragma unroll
                for (int n = 0; n < 2; ++n) acc[a][b][m][n] = (f32x4){0.f, 0.f, 0.f, 0.f};
    bf16x8 At[4][2], B0[2][2], B1[2][2]; v8i_t At8[4], B08[2], B18[2];
    unsigned vgC[2][2], vgN[2][2];
    PG8_LAS unsigned short* gtab = (PG8_LAS unsigned short*)(lds + STAGE_BYTES);
    const unsigned gcb = (unsigned)(((tid & 7) ^ ((((tid >> 4) & 7)) ^ (((((tid >> 4) & 7)) & 2) << 1))) * 16);
#define PG8_GLOAD(dst, ui_) do { _Pragma("unroll") for (int h_ = 0; h_ < 2; ++h_) _Pragma("unroll") for (int i_ = 0; i_ < 2; ++i_) \
        dst[h_][i_] = (unsigned)gtab[(ui_) * 256 + h_ * 128 + i_ * 64 + (tid >> 3)] * (unsigned)pitch + gcb; } while (0)
    if constexpr (GATHER) {
        Unit uu;
        for (int i = 0; S.next(i, uu); ++i) if (tid < 256) gtab[i * 256 + tid] = (unsigned short)S.rowtok[uu.pm * 256 + tid];
        __syncthreads();
        PG8_GLOAD(vgC, 0);
    }
    const char* cA = GATHER ? (const char*)g.A : (const char*)g.A + (size_t)cur.pm * tstep; const char* cB = (const char*)g.Bt + (size_t)cur.pe * g.bstride + (size_t)cur.pn * tstep;
#define PG8_STAGE_A(b, gb) do { if constexpr (GATHER) { PG8_STAGE(PG8_SA(b, 0), gb, vgC[0]); PG8_STAGE(PG8_SA(b, 1), gb, vgC[1]); } \
        else { PG8_STAGE(PG8_SA(b, 0), gb, voffA); PG8_STAGE(PG8_SA(b, 1), (gb) + hstep, voffA); } } while (0)
    PG8_STAGE(PG8_SB(0, 0), cB, voffB); PG8_STAGE(PG8_SB(0, 1), cB + hstep, voffB); PG8_STAGE_A(0, cA);
    if (wr == 1) PG8_BAR;
    PG8_WAIT_V(2); PG8_BAR;
    PG8_STAGE(PG8_SB(1, 0), cB + kstep, voffB); PG8_STAGE(PG8_SB(1, 1), cB + hstep + kstep, voffB);
    PG8_WAIT_V(4); PG8_BAR;
    for (;;) {
        const bool has_next = S.next(ui + 1, nxt);
        const char* nA = GATHER ? cA : (has_next ? (const char*)g.A + (size_t)nxt.pm * tstep : cA);
        const char* nB = has_next ? (const char*)g.Bt + (size_t)nxt.pe * g.bstride + (size_t)nxt.pn * tstep : cB;
        for (int t = 0; t < nt; t += 2) {
            const bool last = (t == nt - 2);
            const char* a1 = cA + (size_t)(t + 1) * kstep;
            const char* a2 = last ? nA : cA + (size_t)(t + 2) * kstep; const char* b2 = last ? nB : cB + (size_t)(t + 2) * kstep;
            const char* b3 = b2 + kstep;
            if constexpr (GATHER) { if (last) PG8_GLOAD(vgN, has_next ? ui + 1 : ui); }
            PG8_LDB(B0, 0, 0); PG8_LDB(B1, 0, 1); PG8_SCHED; PG8_LDA(At, 0, 0); PG8_STAGE_A(1, a1);
            if constexpr (GATHER) { if (last) {
#pragma unroll
                for (int h_ = 0; h_ < 2; ++h_) { vgC[h_][0] = vgN[h_][0]; vgC[h_][1] = vgN[h_][1]; } } }
            PG8_WAIT_V(8); PG8_WAIT_L(0); PG8_BAR; PG8_MMA(0, 0, At, B0); PG8_MMA(0, 1, At, B1); PG8_BAR; PG8_SCHED;
            PG8_LDA(At, 0, 1); PG8_STAGE(PG8_SB(0, 0), b2, voffB); PG8_STAGE(PG8_SB(0, 1), b2 + hstep, voffB);
            PG8_WAIT_V(6); PG8_WAIT_L(0); PG8_BAR; PG8_MMA(1, 0, At, B0); PG8_MMA(1, 1, At, B1); PG8_BAR; PG8_SCHED;
            PG8_LDB(B0, 1, 0); PG8_LDB(B1, 1, 1); PG8_SCHED; PG8_LDA(At, 1, 0); PG8_STAGE_A(0, a2);
            PG8_WAIT_V(8); PG8_WAIT_L(0); PG8_BAR; PG8_MMA(0, 0, At, B0); PG8_MMA(0, 1, At, B1); PG8_BAR; PG8_SCHED;
            PG8_LDA(At, 1, 1); PG8_STAGE(PG8_SB(1, 0), b3, voffB); PG8_STAGE(PG8_SB(1, 1), b3 + hstep, voffB);
            PG8_WAIT_V(6); PG8_WAIT_L(0); PG8_BAR; PG8_MMA(1, 0, At, B0); PG8_MMA(1, 1, At, B1); PG8_BAR; PG8_SCHED;
        }
        if constexpr (ALIGN_EPI) { if (wr == 0) PG8_BAR; }
        if constexpr (FP8) asm volatile("s_nop 15\n\ts_nop 15" ::: "memory");
        E(acc, cur, wr, wc, fr, fq);
        if (!has_next) break;
#pragma unroll
        for (int a = 0; a < 2; ++a)
#pragma unroll
            for (int b = 0; b < 2; ++b)
#pragma unroll
                for (int m = 0; m < 4; ++m)
#pragma unroll
                    for (int n = 0; n < 2; ++n) acc[a][b][m][n] = (f32x4){0.f, 0.f, 0.f, 0.f};
        cur = nxt; cA = nA; cB = nB; ++ui;
        if constexpr (ALIGN_EPI) { if (wr == 1) PG8_BAR; }
    }
    PG8_WAIT_V(0);
    if constexpr (!ALIGN_EPI) { if (wr == 0) PG8_BAR; }
    PG8_BAR;
#undef PG8_SA
#undef PG8_SB
#undef PG8_STAGE
#undef PG8_STAGE_A
#undef PG8_GLOAD
#undef PG8_LDA
#undef PG8_LDB
#undef PG8_MMA
#undef PG8_LD8
#undef PG8_WAIT_V
#undef PG8_WAIT_L
#undef PG8_BAR
#undef PG8_SCHED
}

struct EpiInProj {
    static constexpr bool PERM = true;
    bf16_t* proj; float* beta; float* gdec; const float* a_log; const float* dt_bias; const float* xs; const float* wsc;
    __device__ __forceinline__ void operator()(const f32x4 (&acc)[2][2][4][2], const Unit& u, int wr, int wc, int fr, int fq) const {
        const int row0 = u.pm * BM + wr * 64 + fr;
        float rsv[2][4];
#pragma unroll
        for (int ai = 0; ai < 2; ++ai)
#pragma unroll
            for (int m = 0; m < 4; ++m) rsv[ai][m] = xs[row0 + ai * HALF + m * 16];
        if (u.pn < PROJW / BM) {
            const int col0 = u.pn * BM + wc * 32 + 8 * fq;
            f32x4 cs[2][2];
#pragma unroll
            for (int bj = 0; bj < 2; ++bj)
#pragma unroll
                for (int n = 0; n < 2; ++n) cs[bj][n] = *(const f32x4*)(wsc + col0 + bj * HALF + 4 * n);
#pragma unroll
            for (int ai = 0; ai < 2; ++ai)
#pragma unroll
                for (int m = 0; m < 4; ++m) { const int row = row0 + ai * HALF + m * 16; const float rs = rsv[ai][m]; bf16_t* rowp = proj + (size_t)row * PROJW + col0;
#pragma unroll
                    for (int bj = 0; bj < 2; ++bj) { const f32x4 v0 = __builtin_convertvector(__builtin_bit_cast(v4i_t, acc[ai][bj][m][0]), f32x4) * rs * cs[bj][0], v1 = __builtin_convertvector(__builtin_bit_cast(v4i_t, acc[ai][bj][m][1]), f32x4) * rs * cs[bj][1];
                        u32x4 w; w.x = cvt_pk_bf16(v0[0], v0[1]); w.y = cvt_pk_bf16(v0[2], v0[3]); w.z = cvt_pk_bf16(v1[0], v1[1]); w.w = cvt_pk_bf16(v1[2], v1[3]);
                        *(u32x4*)(rowp + bj * HALF) = w; } }
        } else if (wc == 0 && fq < 2) {
            const int colb = u.pn * BM + 8 * fq;
#pragma unroll
            for (int ai = 0; ai < 2; ++ai)
#pragma unroll
                for (int m = 0; m < 4; ++m) { const int row = row0 + ai * HALF + m * 16; const float rs = rsv[ai][m];
#pragma unroll
                    for (int n = 0; n < 2; ++n)
#pragma unroll
                        for (int j = 0; j < 4; ++j) { const int hh = 4 * n + j; const float v = (float)__builtin_bit_cast(v4i_t, acc[ai][0][m][n])[j] * rs * wsc[colb + hh];
                            if (fq == 0) beta[(size_t)row * 8 + hh] = sigmoidf_(v);
                            else gdec[(size_t)row * 8 + hh] = -__expf(a_log[hh]) * softplusf_(v + dt_bias[hh]); } }
        }
    }
};
struct EpiOutProj {
    static constexpr bool PERM = false;
    const float* x; bf16_t* h;
    __device__ __forceinline__ void operator()(const f32x4 (&acc)[2][2][4][2], const Unit& u, int wr, int wc, int fr, int fq) const {
        const int row0 = u.pm * BM + wr * 64 + fr, col0 = u.pn * BM + wc * 32 + 4 * fq;
#pragma unroll
        for (int ai = 0; ai < 2; ++ai) {
            f32x4 xv[4][2][2];
#pragma unroll
            for (int m = 0; m < 4; ++m)
#pragma unroll
                for (int bj = 0; bj < 2; ++bj)
#pragma unroll
                    for (int n = 0; n < 2; ++n) xv[m][bj][n] = *(const f32x4*)(x + (size_t)(row0 + ai * HALF + m * 16) * D + col0 + bj * HALF + n * 16);
#pragma unroll
            for (int m = 0; m < 4; ++m) { const size_t off = (size_t)(row0 + ai * HALF + m * 16) * D + col0;
#pragma unroll
                for (int bj = 0; bj < 2; ++bj)
#pragma unroll
                    for (int n = 0; n < 2; ++n) { const f32x4 v = xv[m][bj][n] + acc[ai][bj][m][n];
                        u32x2 w; w.x = cvt_pk_bf16(v[0], v[1]); w.y = cvt_pk_bf16(v[2], v[3]); *(u32x2*)(h + off + bj * HALF + n * 16) = w; } }
        }
    }
};
struct EpiSwiGLU {
    static constexpr bool PERM = true;
    unsigned char* act; const float* bgu; const float* rowscale;
    __device__ __forceinline__ void operator()(const f32x4 (&acc)[2][2][4][2], const Unit& u, int wr, int wc, int fr, int fq) const {
        const int row0 = u.pm * BM + wr * 64 + fr, col0 = u.pn * HALF + wc * 32 + 8 * fq;
        const float* bg = bgu + (size_t)u.pe * 4096 + col0;
        f32x4 bg0 = *(const f32x4*)(bg), bg1 = *(const f32x4*)(bg + 4), bl0 = *(const f32x4*)(bg + 2048), bl1 = *(const f32x4*)(bg + 2048 + 4);
        float rsv[2][4];
#pragma unroll
        for (int ai = 0; ai < 2; ++ai)
#pragma unroll
            for (int m = 0; m < 4; ++m) rsv[ai][m] = rowscale[row0 + ai * HALF + m * 16];
#pragma unroll
        for (int ai = 0; ai < 2; ++ai)
#pragma unroll
            for (int m = 0; m < 4; ++m) {
                const float SC = rsv[ai][m] * (1.0f / (U_SCALE * W_SCALE));
                f32x4 g0 = acc[ai][0][m][0] * SC + bg0, g1 = acc[ai][0][m][1] * SC + bg1, l0 = acc[ai][1][m][0] * SC + bl0, l1 = acc[ai][1][m][1] * SC + bl1;
                float o[8];
#pragma unroll
                for (int j = 0; j < 4; ++j) {
                    float a = fminf(g0[j], 7.0f), b = __builtin_amdgcn_fmed3f(l0[j], -7.0f, 7.0f); o[j] = a * __builtin_amdgcn_rcpf(1.0f + __builtin_amdgcn_exp2f(-2.4554669595930156f * a)) * (b * ACT_SCALE + ACT_SCALE);
                    float c = fminf(g1[j], 7.0f), d = __builtin_amdgcn_fmed3f(l1[j], -7.0f, 7.0f); o[4 + j] = c * __builtin_amdgcn_rcpf(1.0f + __builtin_amdgcn_exp2f(-2.4554669595930156f * c)) * (d * ACT_SCALE + ACT_SCALE); }
                u32x2 w; { int t0_ = __builtin_amdgcn_cvt_pk_fp8_f32(o[0], o[1], 0, false); t0_ = __builtin_amdgcn_cvt_pk_fp8_f32(o[2], o[3], t0_, true); int t1_ = __builtin_amdgcn_cvt_pk_fp8_f32(o[4], o[5], 0, false); t1_ = __builtin_amdgcn_cvt_pk_fp8_f32(o[6], o[7], t1_, true); w.x = (unsigned)t0_; w.y = (unsigned)t1_; }
                *(u32x2*)(act + (size_t)(row0 + ai * HALF + m * 16) * FF + col0) = w; }
    }
};
struct EpiDown {
    static constexpr bool PERM = true;
    unsigned char* y; const float* bd;
    __device__ __forceinline__ void operator()(const f32x4 (&acc)[2][2][4][2], const Unit& u, int wr, int wc, int fr, int fq) const {
        const int row0 = u.pm * BM + wr * 64 + fr, col0 = u.pn * BM + wc * 32 + 8 * fq;
        const float* bp = bd + (size_t)u.pe * D + col0;
        f32x4 bv[2][2];
#pragma unroll
        for (int bj = 0; bj < 2; ++bj)
#pragma unroll
            for (int n = 0; n < 2; ++n) bv[bj][n] = *(const f32x4*)(bp + bj * HALF + 4 * n) * Y_SCALE;
#pragma unroll
        for (int ai = 0; ai < 2; ++ai)
#pragma unroll
            for (int m = 0; m < 4; ++m) { unsigned char* rowp = y + (size_t)(row0 + ai * HALF + m * 16) * D + col0;
#pragma unroll
                for (int bj = 0; bj < 2; ++bj) { constexpr float SC = Y_SCALE / (ACT_SCALE * W_SCALE); const f32x4 v0 = acc[ai][bj][m][0] * SC + bv[bj][0], v1 = acc[ai][bj][m][1] * SC + bv[bj][1];
                    u32x2 w; w.x = pk4_fp8(v0[0], v0[1], v0[2], v0[3]); w.y = pk4_fp8(v1[0], v1[1], v1[2], v1[3]);
                    *(u32x2*)(rowp + bj * HALF) = w; } }
    }
};
}

struct Ptrs {
    const float *x, *attn_norm_w, *w_in, *q_norm_w, *k_norm_w, *sinks, *conv_w, *a_log, *dt_bias, *dn_norm_w, *w_out, *ffn_norm_w, *w_router, *b_router, *w_gate_up, *b_gate_up, *w_down, *b_down;
    float* out; unsigned char* ws;
};

#define LAS __attribute__((address_space(3)))
__device__ __forceinline__ bf16x8 pack8(float a0, float a1, float a2, float a3, float a4, float a5, float a6, float a7) {
    u32x4 w; w.x = pg8::cvt_pk_bf16(a0, a1); w.y = pg8::cvt_pk_bf16(a2, a3); w.z = pg8::cvt_pk_bf16(a4, a5); w.w = pg8::cvt_pk_bf16(a6, a7);
    return __builtin_bit_cast(bf16x8, w);
}
__device__ __forceinline__ void unpack8(const u32x4 w, float (&f)[8]) {
    f[0] = __uint_as_float(w.x << 16); f[1] = __uint_as_float(w.x & 0xffff0000u); f[2] = __uint_as_float(w.y << 16); f[3] = __uint_as_float(w.y & 0xffff0000u);
    f[4] = __uint_as_float(w.z << 16); f[5] = __uint_as_float(w.z & 0xffff0000u); f[6] = __uint_as_float(w.w << 16); f[7] = __uint_as_float(w.w & 0xffff0000u);
}
#define MFMA16(a, b, c) __builtin_amdgcn_mfma_f32_16x16x32_bf16((a), (b), (c), 0, 0, 0)

namespace att {
constexpr int KS_STRIDE = 144, VT_STRIDE = 528;
constexpr int KS_OFF = 0, VT_OFF = 256 * KS_STRIDE, LDS_BYTES = VT_OFF + 64 * VT_STRIDE;
constexpr int NITEMS = BATCH * 16 * 4;
__device__ __forceinline__ void attn_phase(LAS unsigned char* lds, const bf16_t* __restrict__ proj, const float* __restrict__ qw, const float* __restrict__ kw, const float* __restrict__ sinks,
                                           bf16_t* __restrict__ mixed, int lo, int hi, int first, int stride) {
    const int tid = tid_opaque(), w = __builtin_amdgcn_readfirstlane(tid >> 6), lane = tid & 63, qq = lane & 15, kq = lane >> 4;
    float mq = 0.f, mk = 0.f, ms = -1e30f;
    for (int d = 0; d < 64; ++d) { mq = fmaxf(mq, fabsf(qw[d])); mk = fmaxf(mk, fabsf(kw[d])); }
    for (int h = 0; h < 16; ++h) ms = fmaxf(ms, sinks[h]);
    const float L2E = 1.4426950408889634f;
    const float m02 = fmaxf(8.0f * mq * mk, ms) * L2E;
    for (int item = lo + first; item < hi; item += stride) {
        const int kvh = item & 3, qb = (item >> 2) & 15, b = item >> 6;
        const int h = kvh * 4 + (w >> 1), qhalf = w & 1;
        const long tok0 = (long)b * SEQ + (qb - 1) * 128;
        u32x4 qr0[4], qr1[4];
#pragma unroll
        for (int qt = 0; qt < 4; ++qt) { const bf16_t* rp = proj + ((size_t)b * SEQ + qb * 128 + qhalf * 64 + qt * 16 + qq) * PROJW + C_AQ + h * 64 + kq * 8; qr0[qt] = *(const u32x4*)rp; qr1[qt] = *(const u32x4*)(rp + 32); }
        __syncthreads();
        const int tidl = tid_opaque();
        float kwr[8];
#pragma unroll
        for (int j = 0; j < 8; ++j) kwr[j] = kw[(tidl & 7) * 8 + j];
#pragma unroll
        for (int i = 0; i < 4; ++i) {
            const int piece = tidl + 512 * i, key = piece >> 3, dseg = piece & 7; const bool valid = (qb > 0) || (key >= 128);
            u32x4 kr = (u32x4){0u, 0u, 0u, 0u}, vr = (u32x4){0u, 0u, 0u, 0u};
            if (valid) { const bf16_t* rp = proj + (size_t)(tok0 + key) * PROJW + kvh * 64 + dseg * 8; kr = *(const u32x4*)(rp + C_AK); vr = *(const u32x4*)(rp + C_AV); }
            float kf[8]; unpack8(kr, kf);
            float ss = 0.f;
#pragma unroll
            for (int j = 0; j < 8; ++j) ss += kf[j] * kf[j];
            ss += __shfl_xor(ss, 1); ss += __shfl_xor(ss, 2); ss += __shfl_xor(ss, 4);
            const float r = rsqrtf(ss * (1.0f / 64.0f) + 1e-6f);
            *(LAS bf16x8*)(lds + KS_OFF + key * KS_STRIDE + dseg * 16) = pack8(kf[0] * r * kwr[0], kf[1] * r * kwr[1], kf[2] * r * kwr[2], kf[3] * r * kwr[3], kf[4] * r * kwr[4], kf[5] * r * kwr[5], kf[6] * r * kwr[6], kf[7] * r * kwr[7]);
            const unsigned vw[4] = {vr.x, vr.y, vr.z, vr.w};
            const int ks = key ^ (dseg << 3);
#pragma unroll
            for (int j = 0; j < 8; ++j) *(LAS bf16_t*)(lds + VT_OFF + (dseg * 8 + j) * VT_STRIDE + ks * 2) = (bf16_t)((j & 1) ? (vw[j >> 1] >> 16) : (vw[j >> 1] & 0xffffu));
        }
        __syncthreads();
        bf16x8 Qf[4][2];
        {   float qw0[8], qw1[8];
#pragma unroll
            for (int j = 0; j < 8; ++j) { qw0[j] = qw[kq * 8 + j]; qw1[j] = qw[32 + kq * 8 + j]; }
#pragma unroll
            for (int qt = 0; qt < 4; ++qt) {
                float x0[8], x1[8]; unpack8(qr0[qt], x0); unpack8(qr1[qt], x1);
                float ss = 0.f;
#pragma unroll
                for (int j = 0; j < 8; ++j) ss += x0[j] * x0[j] + x1[j] * x1[j];
                ss += __shfl_xor(ss, 16); ss += __shfl_xor(ss, 32);
                const float r = rsqrtf(ss * (1.0f / 64.0f) + 1e-6f) * 0.125f * L2E;
                Qf[qt][0] = pack8(x0[0] * r * qw0[0], x0[1] * r * qw0[1], x0[2] * r * qw0[2], x0[3] * r * qw0[3], x0[4] * r * qw0[4], x0[5] * r * qw0[5], x0[6] * r * qw0[6], x0[7] * r * qw0[7]);
                Qf[qt][1] = pack8(x1[0] * r * qw1[0], x1[1] * r * qw1[1], x1[2] * r * qw1[2], x1[3] * r * qw1[3], x1[4] * r * qw1[4], x1[5] * r * qw1[5], x1[6] * r * qw1[6], x1[7] * r * qw1[7]);
            }
        }
        f32x4 O[4][4]; float lsum[4];
#pragma unroll
        for (int qt = 0; qt < 4; ++qt) { lsum[qt] = 0.f;
#pragma unroll
            for (int dt = 0; dt < 4; ++dt) O[qt][dt] = (f32x4){0.f, 0.f, 0.f, 0.f}; }
        const float sl2 = exp2f(-0.5f * (float)(h + 1)) * L2E;
        const int vsw = (qq >> 3) << 3;
#pragma unroll 1
        for (int kt3 = 0; kt3 < 3; ++kt3) {
            const int kt = qhalf + kt3;
#pragma unroll 1
            for (int sp = 0; sp < 2; ++sp) {
                bf16x8 Kf[2][2]; u32x2 Vr[4][2];
#pragma unroll
                for (int h2 = 0; h2 < 2; ++h2) { const int krow = kt * 64 + (2 * sp + h2) * 16 + qq;
                    Kf[h2][0] = *(const LAS bf16x8*)(lds + KS_OFF + krow * KS_STRIDE + kq * 16); Kf[h2][1] = *(const LAS bf16x8*)(lds + KS_OFF + krow * KS_STRIDE + 64 + kq * 16); }
#pragma unroll
                for (int dt = 0; dt < 4; ++dt) { const int off0 = ((kt * 64 + 32 * sp + 4 * kq) ^ ((dt << 4) | vsw)) * 2;
                    const LAS unsigned char* vp = lds + VT_OFF + (dt * 16 + qq) * VT_STRIDE;
                    Vr[dt][0] = *(const LAS u32x2*)(vp + off0); Vr[dt][1] = *(const LAS u32x2*)(vp + (off0 ^ 32)); }
                u32x2 Ph[4][2];
#pragma unroll
                for (int h2 = 0; h2 < 2; ++h2) {
#pragma unroll
                    for (int qt = 0; qt < 4; ++qt) {
                        f32x4 a = MFMA16(Kf[h2][0], Qf[qt][0], ((f32x4){0.f, 0.f, 0.f, 0.f})); a = MFMA16(Kf[h2][1], Qf[qt][1], a);
                        float p[4];
#pragma unroll
                        for (int r = 0; r < 4; ++r) {
                            const int ki = kt * 64 + (2 * sp + h2) * 16 + 4 * kq + r, qi = qhalf * 64 + qt * 16 + qq, dist = 128 + qi - ki;
                            const bool valid = ((unsigned)dist < 128u) && ((qb > 0) || (ki >= 128));
                            const float e = __builtin_amdgcn_exp2f(a[r] - sl2 * (float)dist - m02);
                            p[r] = valid ? e : 0.f; lsum[qt] += p[r];
                        }
                        Ph[qt][h2].x = pg8::cvt_pk_bf16(p[0], p[1]); Ph[qt][h2].y = pg8::cvt_pk_bf16(p[2], p[3]);
                    }
                }
#pragma unroll
                for (int dt = 0; dt < 4; ++dt) {
                    const bf16x8 Vf = __builtin_bit_cast(bf16x8, ((u32x4){Vr[dt][0].x, Vr[dt][0].y, Vr[dt][1].x, Vr[dt][1].y}));
#pragma unroll
                    for (int qt = 0; qt < 4; ++qt) O[qt][dt] = MFMA16(Vf, __builtin_bit_cast(bf16x8, ((u32x4){Ph[qt][0].x, Ph[qt][0].y, Ph[qt][1].x, Ph[qt][1].y})), O[qt][dt]);
                }
            }
        }
        const float es = __builtin_amdgcn_exp2f(sinks[h] * L2E - m02);
#pragma unroll
        for (int qt = 0; qt < 4; ++qt) {
            float l = lsum[qt]; l += __shfl_xor(l, 16); l += __shfl_xor(l, 32);
            const float inv = __builtin_amdgcn_rcpf(l + es);
            bf16_t* op = mixed + ((size_t)b * SEQ + qb * 128 + qhalf * 64 + qt * 16 + qq) * D + h * 64 + 4 * kq;
#pragma unroll
            for (int dt = 0; dt < 4; ++dt) { u32x2 w2; w2.x = pg8::cvt_pk_bf16(O[qt][dt][0] * inv, O[qt][dt][1] * inv); w2.y = pg8::cvt_pk_bf16(O[qt][dt][2] * inv, O[qt][dt][3] * inv); *(u32x2*)(op + dt * 16) = w2; }
        }
    }
}
}
namespace gdn {
constexpr int NITEMS = BATCH * 32 * 8;
constexpr int KS_OFF = 0, QS_OFF = KS_OFF + 64 * 272, KBT_OFF = QS_OFF + 64 * 272, VBT_OFF = KBT_OFF + 128 * 144, PB_OFF = VBT_OFF + 128 * 144;
constexpr int PBUF = 27648, KDT_OFF = PB_OFF + PBUF;
constexpr int GC_OFF = PB_OFF + 2 * PBUF, BT_OFF = GC_OFF + 256, CW_OFF = BT_OFF + 256, PREP_LDS = CW_OFF + 6144;
constexpr int SC_BUF = 57344, SC_OT_OFF = 2 * SC_BUF, SC_OT_STRIDE = 528, SC_NW_OFF = SC_OT_OFF + 64 * SC_OT_STRIDE, SCAN_LDS = SC_NW_OFF + 512;

__device__ __forceinline__ u32x2 pack4(float a, float b, float c, float d) { u32x2 r; r.x = pg8::cvt_pk_bf16(a, b); r.y = pg8::cvt_pk_bf16(c, d); return r; }

__device__ __forceinline__ void conv_load(const bf16_t* __restrict__ proj, size_t t0, int c, int n, int colbase, u32x4 (&r)[4][2]) {
#pragma unroll
    for (int tap = 0; tap < 4; ++tap) {
        const int tr = c - 3 + tap;
        r[tap][0] = (u32x4){0u, 0u, 0u, 0u}; r[tap][1] = r[tap][0];
        if (n > 0 || tr >= 0) { const bf16_t* rp = proj + (size_t)((long)t0 + tr) * PROJW + colbase; r[tap][0] = *(const u32x4*)rp; r[tap][1] = *(const u32x4*)(rp + 8); }
    }
}
__device__ __forceinline__ void conv16(const u32x4 (&r)[4][2], const LAS float* cwm, int seg, float (&out)[16]) {
#pragma unroll
    for (int j = 0; j < 16; ++j) out[j] = 0.f;
#pragma unroll
    for (int tap = 0; tap < 4; ++tap) {
        float x0[8], x1[8]; unpack8(r[tap][0], x0); unpack8(r[tap][1], x1);
        const LAS f32x4* wp = (const LAS f32x4*)(cwm + tap * 128 + seg * 16);
        const f32x4 w0 = wp[0], w1 = wp[1], w2 = wp[2], w3 = wp[3];
#pragma unroll
        for (int j = 0; j < 4; ++j) { out[j] += w0[j] * x0[j]; out[4 + j] += w1[j] * x0[4 + j]; out[8 + j] += w2[j] * x1[j]; out[12 + j] += w3[j] * x1[4 + j]; }
    }
#pragma unroll
    for (int j = 0; j < 16; ++j) out[j] = siluf_(out[j]);
}

__device__ __forceinline__ void prep_phase(LAS unsigned char* lds, const bf16_t* __restrict__ proj, const float* __restrict__ beta, const float* __restrict__ gdec, const float* __restrict__ conv_w,
                                           bf16_t* __restrict__ NEGW, bf16_t* __restrict__ QG, bf16_t* __restrict__ KDT, bf16_t* __restrict__ AM, bf16_t* __restrict__ UT, float* __restrict__ GLAST,
                                           int n0, int ns, int first, int stride) {
    const int tid = tid_opaque(), w = __builtin_amdgcn_readfirstlane(tid >> 6), lane = tid & 63, qq = lane & 15, kq = lane >> 4;
    const int c = tid >> 3, seg = tid & 7;
    LAS float* GC = (LAS float*)(lds + GC_OFF); LAS float* BT = (LAS float*)(lds + BT_OFF); LAS float* CW = (LAS float*)(lds + CW_OFF);
    int cur_hh = -1;
    const int nv = BATCH * 8 * ns;
#define PREP_ITEM(v_) ((((v_) / (8 * ns)) * 32 + n0 + (((v_) >> 3) % ns)) * 8 + ((v_) & 7))
    u32x4 rq[4][2], rk[4][2];
#define PREP_LOAD(item_) do { const int hh_ = (item_) & 7, n_ = ((item_) >> 3) & 31, b_ = (item_) >> 8; const size_t t0_ = (size_t)b_ * SEQ + n_ * 64; const int tl_ = tid_opaque(), c_ = tl_ >> 3, sg_ = tl_ & 7; \
        conv_load(proj, t0_, c_, n_, C_DQ + hh_ * 128 + sg_ * 16, rq); conv_load(proj, t0_, c_, n_, C_DK + hh_ * 128 + sg_ * 16, rk); } while (0)
    if (first < nv) { const int it0 = PREP_ITEM(first); PREP_LOAD(it0); }
    for (int vi = first; vi < nv; vi += stride) {
        const int item = PREP_ITEM(vi);
        const int hh = item & 7, n = (item >> 3) & 31, b = item >> 8;
        const size_t t0 = (size_t)b * SEQ + n * 64;
        u32x4 rv[4][2]; { const int tl_ = tid_opaque(); conv_load(proj, t0, tl_ >> 3, n, C_DV + hh * 128 + (tl_ & 7) * 16, rv); }
        __syncthreads();
        if (hh != cur_hh) { for (int i = tid; i < 1536; i += 512) { const int mtx = i >> 9, rem = i & 511, tap = rem >> 7, ch = rem & 127; CW[i] = conv_w[tap * 3072 + mtx * 1024 + hh * 128 + ch]; } cur_hh = hh; }
        float gv = gdec[(t0 + lane) * 8 + hh];
#pragma unroll
        for (int o = 1; o < 64; o <<= 1) { const float t = __shfl_up(gv, o); if (lane >= o) gv += t; }
        const float glast = __shfl(gv, 63);
        const float gcc = __shfl(gv, (w * 8 + (lane >> 3)) & 63);
        const float bc = beta[(t0 + c) * 8 + hh];
        if (w == 0) { GC[lane] = gv; BT[lane] = beta[(t0 + lane) * 8 + hh]; }
        if (tid == 0) GLAST[item] = __expf(glast);
        __syncthreads();
        const float egc = __expf(gcc), edk = __expf(glast - gcc);
        const int cs = c ^ (seg << 3);
        {
            float qv[16]; conv16(rq, CW, seg, qv);
            float ss = 0.f;
#pragma unroll
            for (int j = 0; j < 16; ++j) ss += qv[j] * qv[j];
            ss += __shfl_xor(ss, 1); ss += __shfl_xor(ss, 2); ss += __shfl_xor(ss, 4);
            const float rq = rsqrtf(ss + 1e-6f) * 0.08838834764831845f;
#pragma unroll
            for (int j = 0; j < 16; ++j) qv[j] *= rq;
            LAS unsigned char* qp = lds + QS_OFF + c * 272 + seg * 32;
            *(LAS bf16x8*)qp = pack8(qv[0], qv[1], qv[2], qv[3], qv[4], qv[5], qv[6], qv[7]); *(LAS bf16x8*)(qp + 16) = pack8(qv[8], qv[9], qv[10], qv[11], qv[12], qv[13], qv[14], qv[15]);
            bf16_t* qg = QG + (size_t)item * 8192;
#pragma unroll
            for (int q4 = 0; q4 < 4; ++q4)
                *(u32x2*)(qg + ((((c >> 4) * 4 + (seg >> 1)) * 64 + q4 * 16 + (c & 15)) * 8 + (seg & 1) * 4)) = pack4(qv[4 * q4] * egc, qv[4 * q4 + 1] * egc, qv[4 * q4 + 2] * egc, qv[4 * q4 + 3] * egc);
        }
        {
            float kv[16]; conv16(rk, CW + 512, seg, kv);
            float ss = 0.f;
#pragma unroll
            for (int j = 0; j < 16; ++j) ss += kv[j] * kv[j];
            ss += __shfl_xor(ss, 1); ss += __shfl_xor(ss, 2); ss += __shfl_xor(ss, 4);
            const float rk = rsqrtf(ss + 1e-6f);
#pragma unroll
            for (int j = 0; j < 16; ++j) kv[j] *= rk;
            LAS unsigned char* kp = lds + KS_OFF + c * 272 + seg * 32;
            *(LAS bf16x8*)kp = pack8(kv[0], kv[1], kv[2], kv[3], kv[4], kv[5], kv[6], kv[7]); *(LAS bf16x8*)(kp + 16) = pack8(kv[8], kv[9], kv[10], kv[11], kv[12], kv[13], kv[14], kv[15]);
            const float sb = bc * egc;
#pragma unroll
            for (int j = 0; j < 16; ++j) { *(LAS bf16_t*)(lds + KBT_OFF + (seg * 16 + j) * 144 + cs * 2) = f2bf(kv[j] * sb); *(LAS bf16_t*)(lds + KDT_OFF + (seg * 16 + j) * 144 + cs * 2) = f2bf(kv[j] * edk); }
        }
        {
            float vv[16]; conv16(rv, CW + 1024, seg, vv);
#pragma unroll
            for (int j = 0; j < 16; ++j) *(LAS bf16_t*)(lds + VBT_OFF + (seg * 16 + j) * 144 + cs * 2) = f2bf(vv[j] * bc);
        }
        __syncthreads();
        {   bf16_t* kd = KDT + (size_t)item * 8192;
#pragma unroll
            for (int i = 0; i < 4; ++i) { const int piece = tid + 512 * i, dk = piece >> 4, pp = piece & 15;
                const u32x2 v = *(const LAS u32x2*)(lds + KDT_OFF + dk * 144 + (((pp >> 1) ^ (dk >> 4)) * 16) + (pp & 1) * 8);
                *(u32x2*)(kd + ((((dk >> 4) * 2 + (pp >> 3)) * 64 + (pp & 3) * 16 + (dk & 15)) * 8 + ((pp >> 2) & 1) * 4)) = v; }
        }
#pragma unroll
        for (int tsel = 0; tsel < 2; ++tsel) {
            const int ti = 2 * w + tsel, ta = ti >> 2, tb = ti & 3;
            f32x4 akk = (f32x4){0.f, 0.f, 0.f, 0.f}, aqk = akk;
#pragma unroll
            for (int s4 = 0; s4 < 4; ++s4) {
                const bf16x8 A = *(const LAS bf16x8*)(lds + KS_OFF + (16 * ta + qq) * 272 + s4 * 64 + kq * 16);
                const bf16x8 Bk = *(const LAS bf16x8*)(lds + KS_OFF + (16 * tb + qq) * 272 + s4 * 64 + kq * 16);
                const bf16x8 Bq = *(const LAS bf16x8*)(lds + QS_OFF + (16 * tb + qq) * 272 + s4 * 64 + kq * 16);
                akk = MFMA16(A, Bk, akk); aqk = MFMA16(A, Bq, aqk);
            }
            const int y = 16 * tb + qq, x0 = 16 * ta + 4 * kq;
            const float gcy = GC[y], by = BT[y];
            float v1[4], v2[4], xv[4], av[4];
#pragma unroll
            for (int r = 0; r < 4; ++r) { const int x = x0 + r; const float gcx = GC[x], bx = BT[x];
                const float e_yx = (y >= x) ? __expf(gcy - gcx) : 0.f;
                const float e_xy = (x > y) ? __expf(gcx - gcy) : 0.f;
                v1[r] = (y > x) ? by * akk[r] * e_yx : 0.f;
                v2[r] = bx * akk[r] * e_xy;
                xv[r] = ((y == x) ? 1.f : 0.f) - v1[r];
                av[r] = aqk[r] * e_yx; }
            *(LAS u32x2*)(lds + PB_OFF + y * 144 + x0 * 2) = pack4(v1[0], v1[1], v1[2], v1[3]);
            *(LAS u32x2*)(lds + PB_OFF + 9216 + y * 144 + x0 * 2) = pack4(v2[0], v2[1], v2[2], v2[3]);
            *(LAS u32x2*)(lds + PB_OFF + 18432 + y * 144 + x0 * 2) = pack4(xv[0], xv[1], xv[2], xv[3]);
            *(u32x2*)(AM + (size_t)item * 4096 + (((tb * 2 + (ta >> 1)) * 64 + lane) * 8 + (ta & 1) * 4)) = pack4(av[0], av[1], av[2], av[3]);
        }
        __syncthreads();
        if (vi + stride < nv) { const int itn = PREP_ITEM(vi + stride); PREP_LOAD(itn); }
#pragma unroll 1
        for (int ph = 0; ph <= 5; ++ph) {
            const int bc_ = PB_OFF + (ph & 1) * PBUF, bn_ = PB_OFF + ((ph + 1) & 1) * PBUF;
            const int pa_cur = bc_, pt_cur = bc_ + 9216, x_new = bc_ + 18432, pa_new = bn_, pt_new = bn_ + 9216, x_prev = bn_ + 18432;
#pragma unroll
            for (int tsel = 0; tsel < 2; ++tsel) {
                const int ti = 2 * w + tsel, ta = ti >> 2, tb = ti & 3;
                const int ra = (16 * ta + qq) * 144 + kq * 16, rb = (16 * tb + qq) * 144 + kq * 16, wo = (16 * tb + qq) * 144 + (16 * ta + 4 * kq) * 2;
                const bf16x8 PAa0 = *(const LAS bf16x8*)(lds + pa_cur + ra), PAa1 = *(const LAS bf16x8*)(lds + pa_cur + ra + 64);
                const bf16x8 PTa0 = *(const LAS bf16x8*)(lds + pt_cur + ra), PTa1 = *(const LAS bf16x8*)(lds + pt_cur + ra + 64);
                if (ph < 5) {
                    const bf16x8 PAb0 = *(const LAS bf16x8*)(lds + pa_cur + rb), PAb1 = *(const LAS bf16x8*)(lds + pa_cur + rb + 64);
                    const bf16x8 PTb0 = *(const LAS bf16x8*)(lds + pt_cur + rb), PTb1 = *(const LAS bf16x8*)(lds + pt_cur + rb + 64);
                    f32x4 d1 = MFMA16(PAa0, PTb0, ((f32x4){0.f, 0.f, 0.f, 0.f})); d1 = MFMA16(PAa1, PTb1, d1);
                    f32x4 d2 = MFMA16(PTa0, PAb0, ((f32x4){0.f, 0.f, 0.f, 0.f})); d2 = MFMA16(PTa1, PAb1, d2);
                    *(LAS u32x2*)(lds + pt_new + wo) = pack4(d1[0], d1[1], d1[2], d1[3]);
                    *(LAS u32x2*)(lds + pa_new + wo) = pack4(d2[0], d2[1], d2[2], d2[3]);
                }
                if (ph >= 1) {
                    const bf16x8 Xb0 = *(const LAS bf16x8*)(lds + x_prev + rb), Xb1 = *(const LAS bf16x8*)(lds + x_prev + rb + 64);
                    const u32x2 xc = *(const LAS u32x2*)(lds + x_prev + wo);
                    f32x4 d3 = (f32x4){__uint_as_float(xc.x << 16), __uint_as_float(xc.x & 0xffff0000u), __uint_as_float(xc.y << 16), __uint_as_float(xc.y & 0xffff0000u)};
                    d3 = MFMA16(PTa0, Xb0, d3); d3 = MFMA16(PTa1, Xb1, d3);
                    *(LAS u32x2*)(lds + x_new + wo) = pack4(d3[0], d3[1], d3[2], d3[3]);
                }
            }
            __syncthreads();
        }
        {   const int x5 = PB_OFF + PBUF + 18432;
#pragma unroll
            for (int tt = 0; tt < 4; ++tt) {
                const int tu = 4 * w + tt;
                {   const int ta = tu & 3, tb = tu >> 2;
                    f32x4 d = (f32x4){0.f, 0.f, 0.f, 0.f};
#pragma unroll
                    for (int s2 = 0; s2 < 2; ++s2) d = MFMA16(*(const LAS bf16x8*)(lds + x5 + (16 * ta + qq) * 144 + s2 * 64 + kq * 16), *(const LAS bf16x8*)(lds + VBT_OFF + (16 * tb + qq) * 144 + (((4 * s2 + kq) ^ tb) * 16)), d);
                    *(u32x2*)(UT + (size_t)item * 8192 + ((tb * 4 + ta) * 64 + lane) * 4) = pack4(d[0], d[1], d[2], d[3]); }
                {   const int ta = tu >> 2, tb = tu & 3;
                    f32x4 d = (f32x4){0.f, 0.f, 0.f, 0.f};
#pragma unroll
                    for (int s2 = 0; s2 < 2; ++s2) d = MFMA16(*(const LAS bf16x8*)(lds + KBT_OFF + (16 * ta + qq) * 144 + (((4 * s2 + kq) ^ ta) * 16)), *(const LAS bf16x8*)(lds + x5 + (16 * tb + qq) * 144 + s2 * 64 + kq * 16), d);
                    *(u32x2*)(NEGW + (size_t)item * 8192 + (((tb * 4 + (ta >> 1)) * 64 + lane) * 8 + (ta & 1) * 4)) = pack4(-d[0], -d[1], -d[2], -d[3]); }
            }
        }
    }
#undef PREP_LOAD
#undef PREP_ITEM
}

template <class GridBar>
__device__ __forceinline__ void scan_phase(LAS unsigned char* lds, const bf16_t* __restrict__ NEGW, const bf16_t* __restrict__ QG, const bf16_t* __restrict__ KDT, const bf16_t* __restrict__ AM,
                                           const bf16_t* __restrict__ UT, const float* __restrict__ GLAST, const bf16_t* __restrict__ proj, const float* __restrict__ dn_norm_w, bf16_t* __restrict__ mixed, int bh,
                                           int nsplit, const GridBar& gridbar) {
    const int tid = tid_opaque(), w = __builtin_amdgcn_readfirstlane(tid >> 6), lane = tid & 63, qq = lane & 15, kq = lane >> 4;
    const int b = bh >> 3, hh = bh & 7, c = tid >> 3, seg = tid & 7;
    f32x4 S[8];
#pragma unroll
    for (int i = 0; i < 8; ++i) S[i] = (f32x4){0.f, 0.f, 0.f, 0.f};
#define GDN_STAGE(nn, bufoff) do { const size_t it_ = (size_t)((b * 32 + (nn)) * 8 + hh); \
        _Pragma("unroll") for (int i_ = 0; i_ < 7; ++i_) { const bf16_t* src_ = (i_ < 2) ? NEGW + it_ * 8192 + (i_ * 512 + tid) * 8 : (i_ < 4) ? QG + it_ * 8192 + ((i_ - 2) * 512 + tid) * 8 \
            : (i_ < 6) ? KDT + it_ * 8192 + ((i_ - 4) * 512 + tid) * 8 : AM + it_ * 4096 + tid * 8; \
            __builtin_amdgcn_global_load_lds((const unsigned*)src_, (LAS unsigned*)(lds + (bufoff) + i_ * 8192 + w * 1024), 16, 0, 0); } } while (0)
    if (tid < 128) *(LAS float*)(lds + SC_NW_OFF + tid * 4) = dn_norm_w[tid];
    GDN_STAGE(0, 0);
    u32x2 uu_n[4]; float gl_n; u32x4 z0_n, z1_n;
#define GDN_LOADS(nn) do { const size_t it_ = (size_t)((b * 32 + (nn)) * 8 + hh), t0_ = (size_t)b * SEQ + (nn) * 64; \
        const bf16_t* up_ = UT + it_ * 8192 + (w * 4 * 64 + lane) * 4; const float* gp_ = GLAST + it_; const bf16_t* zp_ = proj + (t0_ + c) * PROJW + C_DZ + hh * 128 + seg * 16; \
        asm volatile("global_load_dwordx2 %0, %7, off\n\tglobal_load_dwordx2 %1, %7, off offset:512\n\tglobal_load_dwordx2 %2, %7, off offset:1024\n\tglobal_load_dwordx2 %3, %7, off offset:1536\n\t" \
                     "global_load_dword %4, %8, off\n\tglobal_load_dwordx4 %5, %9, off\n\tglobal_load_dwordx4 %6, %9, off offset:16" \
                     : "=&v"(uu_n[0]), "=&v"(uu_n[1]), "=&v"(uu_n[2]), "=&v"(uu_n[3]), "=&v"(gl_n), "=&v"(z0_n), "=&v"(z1_n) : "v"(up_), "v"(gp_), "v"(zp_) : "memory"); } while (0)
#define GDN_LOADS_WAIT() asm volatile("s_waitcnt vmcnt(0)" : "+v"(uu_n[0]), "+v"(uu_n[1]), "+v"(uu_n[2]), "+v"(uu_n[3]), "+v"(gl_n), "+v"(z0_n), "+v"(z1_n) :: "memory")
    GDN_LOADS(0);
    GDN_LOADS_WAIT();
    __syncthreads();
#pragma unroll 1
    for (int n = 0; n < 32; ++n) {
        const int buf = (n & 1) * SC_BUF;
        const size_t t0 = (size_t)b * SEQ + n * 64;
        f32x4 vn[4];
#pragma unroll
        for (int mt = 0; mt < 4; ++mt) vn[mt] = (f32x4){__uint_as_float(uu_n[mt].x << 16), __uint_as_float(uu_n[mt].x & 0xffff0000u), __uint_as_float(uu_n[mt].y << 16), __uint_as_float(uu_n[mt].y & 0xffff0000u)};
        const float gl = gl_n; const u32x4 z0 = z0_n, z1 = z1_n;
        if (n + 1 == nsplit) gridbar();
        if (n + 1 < 32) { GDN_STAGE(n + 1, SC_BUF - buf); GDN_LOADS(n + 1); }
        bf16x8 Sb[4];
#pragma unroll
        for (int s4 = 0; s4 < 4; ++s4) Sb[s4] = pack8(S[2 * s4][0], S[2 * s4][1], S[2 * s4][2], S[2 * s4][3], S[2 * s4 + 1][0], S[2 * s4 + 1][1], S[2 * s4 + 1][2], S[2 * s4 + 1][3]);
        f32x4 o[4];
        bf16x8 F1[16], F2[16];
#pragma unroll
        for (int i = 0; i < 16; ++i) F1[i] = *(const LAS bf16x8*)(lds + buf + (i * 64 + lane) * 16);
#pragma unroll
        for (int i = 0; i < 16; ++i) F2[i] = *(const LAS bf16x8*)(lds + buf + 16384 + (i * 64 + lane) * 16);
        __builtin_amdgcn_sched_barrier(0);
#pragma unroll
        for (int s4 = 0; s4 < 4; ++s4)
#pragma unroll
            for (int mt = 0; mt < 4; ++mt) vn[mt] = MFMA16(F1[mt * 4 + s4], Sb[s4], vn[mt]);
#pragma unroll
        for (int mt = 0; mt < 4; ++mt) o[mt] = (f32x4){0.f, 0.f, 0.f, 0.f};
#pragma unroll
        for (int s4 = 0; s4 < 4; ++s4)
#pragma unroll
            for (int mt = 0; mt < 4; ++mt) o[mt] = MFMA16(F2[mt * 4 + s4], Sb[s4], o[mt]);
        __builtin_amdgcn_sched_barrier(0);
        bf16x8 F3[8];
#pragma unroll
        for (int i = 0; i < 8; ++i) F3[i] = *(const LAS bf16x8*)(lds + buf + 49152 + (i * 64 + lane) * 16);
#pragma unroll
        for (int i = 0; i < 16; ++i) F1[i] = *(const LAS bf16x8*)(lds + buf + 32768 + (i * 64 + lane) * 16);
        bf16x8 Vb[2];
#pragma unroll
        for (int s2 = 0; s2 < 2; ++s2) Vb[s2] = pack8(vn[2 * s2][0], vn[2 * s2][1], vn[2 * s2][2], vn[2 * s2][3], vn[2 * s2 + 1][0], vn[2 * s2 + 1][1], vn[2 * s2 + 1][2], vn[2 * s2 + 1][3]);
#pragma unroll
        for (int s2 = 0; s2 < 2; ++s2)
#pragma unroll
            for (int mt = 0; mt < 4; ++mt) o[mt] = MFMA16(F3[mt * 2 + s2], Vb[s2], o[mt]);
        __builtin_amdgcn_sched_barrier(0);
#pragma unroll
        for (int mt = 0; mt < 8; ++mt) S[mt] = S[mt] * gl;
#pragma unroll
        for (int s2 = 0; s2 < 2; ++s2)
#pragma unroll
            for (int mt = 0; mt < 8; ++mt) S[mt] = MFMA16(F1[mt * 2 + s2], Vb[s2], S[mt]);
#pragma unroll
        for (int mt = 0; mt < 4; ++mt)
#pragma unroll
            for (int r = 0; r < 4; ++r) *(LAS float*)(lds + SC_OT_OFF + (16 * mt + 4 * kq + r) * SC_OT_STRIDE + (16 * w + qq) * 4) = o[mt][r];
        asm volatile("s_waitcnt lgkmcnt(0)" ::: "memory"); __builtin_amdgcn_s_barrier(); asm volatile("" ::: "memory");
        {   const LAS f32x4* op = (const LAS f32x4*)(lds + SC_OT_OFF + c * SC_OT_STRIDE + seg * 64);
            const f32x4 o0 = op[0], o1 = op[1], o2 = op[2], o3 = op[3];
            float ov[16] = {o0[0], o0[1], o0[2], o0[3], o1[0], o1[1], o1[2], o1[3], o2[0], o2[1], o2[2], o2[3], o3[0], o3[1], o3[2], o3[3]};
            float ss = 0.f;
#pragma unroll
            for (int j = 0; j < 16; ++j) ss += ov[j] * ov[j];
            ss += __shfl_xor(ss, 1); ss += __shfl_xor(ss, 2); ss += __shfl_xor(ss, 4);
            const float r = rsqrtf(ss * (1.0f / 128.0f) + 1e-6f);
            float zf0[8], zf1[8]; unpack8(z0, zf0); unpack8(z1, zf1);
            float nw[16];
#pragma unroll
            for (int j = 0; j < 4; ++j) { const f32x4 t4 = *(const LAS f32x4*)(lds + SC_NW_OFF + (seg * 16 + 4 * j) * 4); nw[4 * j] = t4[0]; nw[4 * j + 1] = t4[1]; nw[4 * j + 2] = t4[2]; nw[4 * j + 3] = t4[3]; }
#pragma unroll
            for (int j = 0; j < 8; ++j) { ov[j] = ov[j] * r * nw[j] * siluf_(zf0[j]); ov[8 + j] = ov[8 + j] * r * nw[8 + j] * siluf_(zf1[j]); }
            bf16_t* mp = mixed + (t0 + c) * D + 1024 + hh * 128 + seg * 16;
            *(bf16x8*)mp = pack8(ov[0], ov[1], ov[2], ov[3], ov[4], ov[5], ov[6], ov[7]); *(bf16x8*)(mp + 8) = pack8(ov[8], ov[9], ov[10], ov[11], ov[12], ov[13], ov[14], ov[15]);
        }
        GDN_LOADS_WAIT();
        __syncthreads();
    }
#undef GDN_LOADS_WAIT
#undef GDN_STAGE
#undef GDN_LOADS
}
}

#define XB_TMO      128
#define XB_XCNT(j)  (256  + 64 * (j))
#define XB_XSUB(j)  (1280 + 64 * (j))
#define XB_XGEN(j)  (2304 + 64 * (j))
#define XB_TOP      3328
#define XB_TOPGEN   3392
#define XCD_BAR_WORDS 3456
#define XB_SPIN_CAP (1u << 18)
__device__ __forceinline__ unsigned xb_ld(unsigned* p)              { return __hip_atomic_load(p, __ATOMIC_RELAXED, __HIP_MEMORY_SCOPE_AGENT); }
__device__ __forceinline__ unsigned xb_add(unsigned* p, unsigned v) { return __hip_atomic_fetch_add(p, v, __ATOMIC_RELAXED, __HIP_MEMORY_SCOPE_AGENT); }
__device__ __forceinline__ unsigned xb_xcc_id() { return (unsigned)__builtin_amdgcn_s_getreg((3 << 11) | 20) & 0xFu; }
#define XB_SPIN(cond, bar) do { unsigned _sp = 0; while (cond) { __builtin_amdgcn_s_sleep(1); \
    if ((++_sp & 255u) == 0u) { if (xb_ld(&(bar)[XB_TMO])) break; if (_sp > XB_SPIN_CAP) { atomicAdd(&(bar)[XB_TMO], 1u); break; } } } } while (0)
struct XcdBarrier { unsigned* bar; unsigned x; volatile LAS unsigned* st; };
__device__ __forceinline__ XcdBarrier xcd_barrier_post(unsigned* bar, volatile LAS unsigned* st) {
    XcdBarrier b; b.bar = bar; b.x = xb_xcc_id(); b.st = st;
    if (threadIdx.x == 0) (void)xb_add(&bar[XB_XCNT(b.x)], 1u);
    return b;
}
__device__ __forceinline__ void xcd_barrier_complete(unsigned* bar, unsigned x, unsigned& nloc, unsigned& nx) {
    const unsigned G = gridDim.x * gridDim.y * gridDim.z;
    unsigned sum, cnt, mine, sp = 0u;
    for (;;) {
        sum = 0u; cnt = 0u; mine = 0u;
#pragma unroll
        for (unsigned j = 0; j < 16; ++j) { const unsigned c = xb_ld(&bar[XB_XCNT(j)]); sum += c; cnt += (c > 0u) ? 1u : 0u; mine = (j == x) ? c : mine; }
        if (sum == G) break;
        __builtin_amdgcn_s_sleep(1);
        if ((++sp & 255u) == 0u) { if (xb_ld(&bar[XB_TMO])) break; if (sp > XB_SPIN_CAP) { atomicAdd(&bar[XB_TMO], 1u); break; } }
    }
    nloc = mine > 0u ? mine : 1u; nx = cnt > 0u ? cnt : 1u;
}
__device__ __forceinline__ void xcd_barrier(const XcdBarrier& b) {
    asm volatile("s_waitcnt vmcnt(0)" ::: "memory");
    __syncthreads();
    if (threadIdx.x == 0) {
        unsigned* bar = b.bar;
        unsigned bx = b.x; asm volatile("" : "+s"(bx));
        __builtin_amdgcn_s_waitcnt(0);
        unsigned nloc = b.st[0], nx = b.st[1];
        if (nloc == 0u) { xcd_barrier_complete(bar, bx, nloc, nx); b.st[0] = nloc; b.st[1] = nx; }
        const unsigned old = xb_add(&bar[XB_XSUB(bx)], 1u);
        const unsigned gen = old / nloc;
        if (old + 1u == (gen + 1u) * nloc) {
            __builtin_amdgcn_fence(__ATOMIC_RELEASE, "agent");
            asm volatile("s_waitcnt vmcnt(0)" ::: "memory");
            const unsigned og = xb_add(&bar[XB_TOP], 1u);
            const unsigned tg = og / nx;
            if (og + 1u == (tg + 1u) * nx) xb_add(&bar[XB_TOPGEN], 1u);
            else XB_SPIN(xb_ld(&bar[XB_TOPGEN]) == tg, bar);
            __builtin_amdgcn_fence(__ATOMIC_ACQUIRE, "agent");
            xb_add(&bar[XB_XGEN(bx)], 1u);
            asm volatile("s_waitcnt vmcnt(0)" ::: "memory");
        } else {
            XB_SPIN(xb_ld(&bar[XB_XGEN(bx)]) == gen, bar);
            __builtin_amdgcn_fence(__ATOMIC_ACQUIRE, "agent");
            asm volatile("s_waitcnt vmcnt(0)" ::: "memory");
        }
    }
    __syncthreads();
}

constexpr int NWAVES = 8;
constexpr int PHASE_LDS = gdn::SCAN_LDS;
constexpr int XB_OFF = PHASE_LDS, LDS_BYTES = PHASE_LDS + 256;
static_assert(gdn::PREP_LDS <= PHASE_LDS && pg8::STAGE_BYTES <= PHASE_LDS && att::LDS_BYTES <= PHASE_LDS && LDS_BYTES <= 163840, "LDS map");

template <int MODE>
__device__ __forceinline__ void wT_tile(LAS float* t, const float* __restrict__ W, bf16_t* __restrict__ WT, int K, int N, int Npad, int tile, int ht, bool active) {
    const int ntn = Npad / 64, ntk = K / 64, per = ntn * ntk;
    const int bz = tile / per, rem = tile % per, n0 = (rem % ntn) * 64, k0 = (rem / ntn) * 64;
    const float* src = W + (size_t)bz * K * N; bf16_t* dst = WT + (size_t)bz * Npad * K;
    if (active) {
#pragma unroll
        for (int p = 0; p < 4; ++p) { const int kk = p * 16 + (ht >> 4), nn = (ht & 15) * 4;
            f32x4 v = (f32x4){0.f, 0.f, 0.f, 0.f};
            if (n0 + nn + 3 < N) v = *(const f32x4*)(src + (size_t)(k0 + kk) * N + n0 + nn);
            t[kk * 65 + nn] = v[0]; t[kk * 65 + nn + 1] = v[1]; t[kk * 65 + nn + 2] = v[2]; t[kk * 65 + nn + 3] = v[3]; }
    }
    __syncthreads();
    if (active) {
        const int n = ht >> 2, ks = (ht & 3) * 16; const int c = n0 + n;
        int drow = c;
        if (MODE == 1) drow = ((c % 2048) / 128) * 256 + (c / 2048) * 128 + (c % 128);
        u32x4 w0, w1;
#define TT(i) t[(ks + (i)) * 65 + n]
        w0.x = pk2(TT(0), TT(1)); w0.y = pk2(TT(2), TT(3)); w0.z = pk2(TT(4), TT(5)); w0.w = pk2(TT(6), TT(7));
        w1.x = pk2(TT(8), TT(9)); w1.y = pk2(TT(10), TT(11)); w1.z = pk2(TT(12), TT(13)); w1.w = pk2(TT(14), TT(15));
#undef TT
        bf16_t* o = dst + (size_t)drow * K + k0 + ks;
        *(u32x4*)o = w0; *(u32x4*)(o + 8) = w1;
    }
    __syncthreads();
}
template <int MODE>
__device__ __forceinline__ void wT_phase(LAS unsigned char* lds, const float* W, bf16_t* WT, int K, int N, int Npad, int batch, int wg, int G) {
    const int tid = tid_opaque(), half = tid >> 8, ht = tid & 255;
    LAS float* t = (LAS float*)(lds + half * 16640);
    const int ntiles = batch * (Npad / 64) * (K / 64);
    for (int base = wg * 2; base < ntiles; base += G * 2) { const int tile = base + half; wT_tile<MODE>(t, W, WT, K, N, Npad, tile < ntiles ? tile : 0, ht, tile < ntiles); }
}
template <int MODE>
__device__ __forceinline__ void wT8_phase(LAS unsigned char* lds, const float* __restrict__ W, unsigned char* __restrict__ WT, int K, int N, int batch, unsigned* ctr) {
    const int tid = tid_opaque(), nn4 = tid & 15, kq = tid >> 4;
    const int ntn = N / 64, ntk = K / 256, per = ntn * ntk, ntiles = batch * per;
    LAS int* q = (LAS int*)(lds + 32768);
    f32x4 v[8], vn[8];
#define WT8_LOAD(dst, tile_) do { const int bz_ = (tile_) / per, rem_ = (tile_) % per, n0_ = (rem_ % ntn) * 64, k0_ = (rem_ / ntn) * 256; \
        const float* src_ = W + (size_t)bz_ * K * N + (size_t)(k0_ + kq * 8) * N + n0_ + nn4 * 4; \
        _Pragma("unroll") for (int r = 0; r < 8; ++r) dst[r] = __builtin_nontemporal_load((const f32x4*)(src_ + (size_t)r * N)); } while (0)
    __syncthreads();
    if (tid == 0) { const int r0 = (int)atomicAdd(ctr, 2u); q[0] = r0; q[1] = r0 + 1; }
    __syncthreads();
    int sup = q[0], supn = q[1], sub = 0;
    __syncthreads();
    int tile = 2 * sup;
    if (tile < ntiles) WT8_LOAD(vn, tile);
    while (tile < ntiles) {
        const int bz = tile / per, rem = tile % per, n0 = (rem % ntn) * 64, k0 = (rem / ntn) * 256;
        const int nxt = sub ? ((supn < 0x3fffffff) ? 2 * supn : 0x7fffffff) : tile + 1;
        int fut = 0x7fffffff;
        if (sub) { if (tid == 0 && nxt < ntiles) fut = (int)atomicAdd(ctr, 1u); }
#pragma unroll
        for (int r = 0; r < 8; ++r) v[r] = vn[r];
        if (nxt < ntiles) WT8_LOAD(vn, nxt);
        __syncthreads();
#pragma unroll
        for (int g = 0; g < 2; ++g)
#pragma unroll
            for (int j = 0; j < 4; ++j)
                *(LAS unsigned*)(lds + (nn4 * 4 + j) * 272 + kq * 8 + g * 4) = pk4_fp8(v[4 * g][j] * W_SCALE, v[4 * g + 1][j] * W_SCALE, v[4 * g + 2][j] * W_SCALE, v[4 * g + 3][j] * W_SCALE);
        if (sub && tid == 0) q[0] = fut;
        __syncthreads();
        unsigned char* dst = WT + (size_t)bz * N * K;
#pragma unroll
        for (int i = 0; i < 2; ++i) { const int pc = tid + 512 * i, row = pc >> 4, sg = pc & 15; const int c = n0 + row;
            int drow = c;
            if (MODE == 1) drow = ((c % 2048) / 128) * 256 + (c / 2048) * 128 + (c % 128);
            __builtin_nontemporal_store(*(const LAS u32x4*)(lds + row * 272 + sg * 16), (u32x4*)(dst + (size_t)drow * K + k0 + sg * 16)); }
        if (sub) { sup = supn; supn = q[0]; }
        sub ^= 1; tile = nxt;
    }
#undef WT8_LOAD
    __syncthreads();
}
__device__ __forceinline__ void rms_phase(const float* x, const float* w, bf16_t* o, float eps, int wg, int G) {
    const int tid = tid_opaque(), wave = tid >> 6, lane = tid & 63;
    for (int row = wg * NWAVES + wave; row < T; row += G * NWAVES) {
        const f32x4* xr = (const f32x4*)(x + (size_t)row * D) + lane; const f32x4* wr = (const f32x4*)w + lane;
        f32x4 v[8]; float s = 0.f;
#pragma unroll
        for (int j = 0; j < 8; ++j) { v[j] = xr[64 * j]; s += (v[j][0] * v[j][0] + v[j][1] * v[j][1]) + (v[j][2] * v[j][2] + v[j][3] * v[j][3]); }
        const float r = rsqrtf(wave_sum(s) * (1.0f / D) + eps);
        u32x2* o8 = (u32x2*)(o + (size_t)row * D) + lane;
#pragma unroll
        for (int j = 0; j < 8; ++j) { const f32x4 g = wr[64 * j]; u32x2 q; q.x = pk2(v[j][0] * r * g[0], v[j][1] * r * g[1]); q.y = pk2(v[j][2] * r * g[2], v[j][3] * r * g[3]); o8[64 * j] = q; }
    }
}
__device__ __forceinline__ unsigned pk4_i8(float a, float b, float c, float d) {
    const int ia = (int)rintf(a), ib = (int)rintf(b), ic = (int)rintf(c), id = (int)rintf(d);
    return ((unsigned)ia & 255u) | (((unsigned)ib & 255u) << 8) | (((unsigned)ic & 255u) << 16) | ((unsigned)id << 24); }
__device__ __forceinline__ void rms8_phase(const float* x, const float* w, unsigned char* o, float* xs, float eps, int wg, int G) {
    const int tid = tid_opaque(), wave = tid >> 6, lane = tid & 63;
    for (int row = wg * NWAVES + wave; row < T; row += G * NWAVES) {
        const f32x4* xr = (const f32x4*)(x + (size_t)row * D) + lane; const f32x4* wr = (const f32x4*)w + lane;
        f32x4 v[8]; float s = 0.f;
#pragma unroll
        for (int j = 0; j < 8; ++j) { v[j] = xr[64 * j]; s += (v[j][0] * v[j][0] + v[j][1] * v[j][1]) + (v[j][2] * v[j][2] + v[j][3] * v[j][3]); }
        const float r = rsqrtf(wave_sum(s) * (1.0f / D) + eps);
        float am = 0.f;
#pragma unroll
        for (int j = 0; j < 8; ++j) { const f32x4 g = wr[64 * j]; v[j][0] *= r * g[0]; v[j][1] *= r * g[1]; v[j][2] *= r * g[2]; v[j][3] *= r * g[3];
            am = fmaxf(am, fmaxf(fmaxf(fabsf(v[j][0]), fabsf(v[j][1])), fmaxf(fabsf(v[j][2]), fabsf(v[j][3])))); }
#pragma unroll
        for (int o2 = 1; o2 < 64; o2 <<= 1) am = fmaxf(am, __shfl_xor(am, o2));
        am = fmaxf(am, 1e-20f);
        const float qs = 127.0f / am;
        unsigned* o4 = (unsigned*)(o + (size_t)row * D) + lane;
#pragma unroll
        for (int j = 0; j < 8; ++j) o4[64 * j] = pk4_i8(v[j][0] * qs, v[j][1] * qs, v[j][2] * qs, v[j][3] * qs);
        if (lane == 0) xs[row] = am * (1.0f / 127.0f);
    }
}
__device__ __forceinline__ void win8_phase(LAS unsigned char* lds, const float* __restrict__ W, unsigned char* __restrict__ WT, float* __restrict__ wsc, int K, int N, int Npad, int wg, int G) {
    const int tid = tid_opaque(), nn4 = tid & 15, kq = tid >> 4;
    LAS float* pm = (LAS float*)(lds + 32768); LAS float* qsv = (LAS float*)(lds + 32768 + 8192);
    for (int task = wg; task < Npad / 64; task += G) {
        const int n0 = task * 64; const bool inb = (n0 + nn4 * 4 + 3 < N);
        f32x4 m4 = (f32x4){0.f, 0.f, 0.f, 0.f};
        const float* src = W + (size_t)(kq * 64) * N + n0 + nn4 * 4;
#pragma unroll 8
        for (int r = 0; r < 64; ++r) { f32x4 v = (f32x4){0.f, 0.f, 0.f, 0.f}; if (inb) v = *(const f32x4*)(src + (size_t)r * N);
            m4[0] = fmaxf(m4[0], fabsf(v[0])); m4[1] = fmaxf(m4[1], fabsf(v[1])); m4[2] = fmaxf(m4[2], fabsf(v[2])); m4[3] = fmaxf(m4[3], fabsf(v[3])); }
        __syncthreads();
        *(LAS f32x4*)(pm + kq * 64 + nn4 * 4) = m4;
        __syncthreads();
        if (tid < 64) { float cm = 0.f;
#pragma unroll
            for (int q = 0; q < 32; ++q) cm = fmaxf(cm, pm[q * 64 + tid]);
            qsv[tid] = cm > 0.f ? 127.0f / cm : 0.f; wsc[n0 + tid] = cm * (1.0f / 127.0f); }
        __syncthreads();
        const f32x4 qs = *(const LAS f32x4*)(qsv + nn4 * 4);
#pragma unroll 1
        for (int kb = 0; kb < K / 256; ++kb) {
            f32x4 v[8];
            const float* s2 = W + (size_t)(kb * 256 + kq * 8) * N + n0 + nn4 * 4;
#pragma unroll
            for (int r = 0; r < 8; ++r) { v[r] = (f32x4){0.f, 0.f, 0.f, 0.f}; if (inb) v[r] = *(const f32x4*)(s2 + (size_t)r * N); }
#pragma unroll
            for (int g = 0; g < 2; ++g)
#pragma unroll
                for (int j = 0; j < 4; ++j)
                    *(LAS unsigned*)(lds + (nn4 * 4 + j) * 272 + kq * 8 + g * 4) = pk4_i8(v[4 * g][j] * qs[j], v[4 * g + 1][j] * qs[j], v[4 * g + 2][j] * qs[j], v[4 * g + 3][j] * qs[j]);
            __syncthreads();
#pragma unroll
            for (int i = 0; i < 2; ++i) { const int pc = tid + 512 * i, row = pc >> 4, sg = pc & 15;
                *(u32x4*)(WT + (size_t)(n0 + row) * K + kb * 256 + sg * 16) = *(const LAS u32x4*)(lds + row * 272 + sg * 16); }
            __syncthreads();
        }
    }
}
__device__ __forceinline__ void wb_phase(const float* nw, const float* wr, float* WB, int wg, int G) {
    const int tid = tid_opaque();
    for (int o = wg * 512 + tid; o < D * NE; o += G * 512) { const int i = o & 3, e = (o >> 2) & 31, kq = (o >> 7) & 3, jj = o >> 9, k = 16 * jj + 4 * kq + i; WB[o] = nw[k] * wr[k * NE + e]; }
}
__device__ __forceinline__ void router_phase(LAS unsigned char* lds, const bf16_t* h, const float* nw, const float* WB, const float* br, unsigned char* u, float* rstd, int* topi, float* gate, int* lrank, int* cnt, int wg, int G, bool count) {
    const int tid = tid_opaque(), wave = __builtin_amdgcn_readfirstlane(tid >> 6), lane = tid & 63, qq = lane & 15, kq = lane >> 4;
    LAS int* lh = (LAS int*)(lds + 65536);
    if (tid < 32) lh[tid] = 0;
    if (wg == 0) ((unsigned*)(u + (size_t)T * D))[tid] = 0u;
#define RT_STAGE(ch_) do { _Pragma("unroll") for (int i_ = 0; i_ < 4; ++i_) \
        __builtin_amdgcn_global_load_lds((const unsigned*)(WB + (size_t)(ch_) * 8192 + (i_ * 512 + tid) * 4), (LAS unsigned*)(lds + ((ch_) & 1) * 32768 + i_ * 8192 + wave * 1024), 16, 0, 0); } while (0)
    RT_STAGE(0);
    for (int i = tid; i < D; i += 512) *(LAS float*)(lds + 65536 + 256 + i * 4) = nw[i];
    const int task = wg * 4 + (wave & 3);
    const int tok = task * 16 + qq;
    const bf16_t* hp = h + (size_t)tok * D + 4 * kq;
    unsigned* up = (unsigned*)(u + (size_t)tok * D + 4 * kq);
    f32x4 acc0 = (f32x4){0.f, 0.f, 0.f, 0.f}, acc1 = acc0; float ssq = 0.f;
    u32x2 hA[16], hB[16];
#define RT_HLOAD(dst, ch_) do { _Pragma("unroll") for (int j2 = 0; j2 < 16; ++j2) dst[j2] = *(const u32x2*)(hp + 16 * ((ch_) * 16 + j2)); } while (0)
#define RT_COMPUTE(src, ch_) do { const LAS unsigned char* bp = lds + ((ch_) & 1) * 32768 + (kq * 32 + qq) * 16; const LAS unsigned char* gp = lds + 65536 + 256 + ((ch_) * 256 + 4 * kq) * 4; \
        _Pragma("unroll") for (int j2 = 0; j2 < 16; ++j2) { const int jj = (ch_) * 16 + j2; const f32x4 hv = (f32x4){__uint_as_float(src[j2].x << 16), __uint_as_float(src[j2].x & 0xffff0000u), __uint_as_float(src[j2].y << 16), __uint_as_float(src[j2].y & 0xffff0000u)}, g = *(const LAS f32x4*)(gp + j2 * 64); \
            const f32x4 b0 = *(const LAS f32x4*)(bp + j2 * 2048), b1 = *(const LAS f32x4*)(bp + j2 * 2048 + 256); \
            ssq += (hv[0] * hv[0] + hv[1] * hv[1]) + (hv[2] * hv[2] + hv[3] * hv[3]); \
            up[4 * jj] = pk4_fp8(hv[0] * g[0] * U_SCALE, hv[1] * g[1] * U_SCALE, hv[2] * g[2] * U_SCALE, hv[3] * g[3] * U_SCALE); \
            _Pragma("unroll") for (int i = 0; i < 4; ++i) { acc0 = __builtin_amdgcn_mfma_f32_16x16x4f32(hv[i], b0[i], acc0, 0, 0, 0); acc1 = __builtin_amdgcn_mfma_f32_16x16x4f32(hv[i], b1[i], acc1, 0, 0, 0); } } } while (0)
    if (wave < 4) RT_HLOAD(hA, 0);
#pragma unroll 1
    for (int ch = 0; ch < 8; ch += 2) {
        asm volatile("s_waitcnt vmcnt(0)" ::: "memory");
        __syncthreads();
        RT_STAGE(ch + 1);
        if (wave < 4) { RT_HLOAD(hB, ch + 1); RT_COMPUTE(hA, ch); }
        asm volatile("s_waitcnt vmcnt(0)" ::: "memory");
        __syncthreads();
        if (ch + 2 < 8) RT_STAGE(ch + 2);
        if (wave < 4) { if (ch + 2 < 8) RT_HLOAD(hA, ch + 2); RT_COMPUTE(hB, ch + 1); }
    }
#undef RT_HLOAD
#undef RT_COMPUTE
#undef RT_STAGE
    if (wave < 4) {
        ssq += __shfl_xor(ssq, 16); ssq += __shfl_xor(ssq, 32);
        const float rs = rsqrtf(ssq * (1.0f / D) + 1e-5f);
        if (kq == 0) rstd[tok] = rs;
        const float be0 = br[qq], be1 = br[16 + qq];
#pragma unroll
        for (int r = 0; r < 4; ++r) {
            const float rr = __shfl(rs, 4 * kq + r);
            float v0 = acc0[r] * rr + be0, v1 = acc1[r] * rr + be1;
            float tv[4]; int ti[4];
#pragma unroll
            for (int k = 0; k < 4; ++k) {
                float bv = (v0 >= v1) ? v0 : v1; int bi = (v0 >= v1) ? qq : 16 + qq;
#pragma unroll
                for (int o = 1; o < 16; o <<= 1) { const float ov = __shfl_xor(bv, o); const int oi = __shfl_xor(bi, o); if (ov > bv || (ov == bv && oi < bi)) { bv = ov; bi = oi; } }
                tv[k] = bv; ti[k] = bi; if (bi == qq) v0 = -INFINITY; if (bi == 16 + qq) v1 = -INFINITY;
            }
            if (qq == 0) { const int row = task * 16 + 4 * kq + r;
                const float e1 = __expf(tv[1] - tv[0]), e2 = __expf(tv[2] - tv[0]), e3 = __expf(tv[3] - tv[0]); const float inv = 1.0f / (1.0f + e1 + e2 + e3);
                *(f32x4*)(gate + row * 4) = (f32x4){inv, e1 * inv, e2 * inv, e3 * inv};
                *(v4i_t*)(topi + row * 4) = (v4i_t){ti[0], ti[1], ti[2], ti[3]};
                if (count) { v4i_t lr;
#pragma unroll
                    for (int k = 0; k < 4; ++k) lr[k] = __hip_atomic_fetch_add(lh + ti[k], 1, __ATOMIC_RELAXED, __HIP_MEMORY_SCOPE_WORKGROUP);
                    *(v4i_t*)(lrank + row * 4) = lr; } }
        }
    }
    __syncthreads();
    if (count && tid < 32) cnt[wg * 32 + tid] = lh[tid];
}
__device__ __forceinline__ void place_scatter_phase(LAS unsigned char* lds, const int* cnt, const int* topi, const int* lrank, const float* rstd, int* rowtok,
                                                    float* rowscale, int* dest, unsigned* ctl, int wg, int G) {
    const int tid = tid_opaque(), wave = __builtin_amdgcn_readfirstlane(tid >> 6), lane = tid & 63;
    LAS int* sa = (LAS int*)lds;
    {   const int e = tid & 31, part = tid >> 5; int s_all = 0, s_bef = 0;
#pragma unroll
        for (int w2 = part * 16; w2 < part * 16 + 16; ++w2) { const int c = cnt[w2 * 32 + e]; s_all += c; s_bef += (w2 < wg) ? c : 0; }
        sa[part * 32 + e] = s_all; sa[512 + part * 32 + e] = s_bef; }
    __syncthreads();
    if (tid < 32) { int t = 0, b = 0;
#pragma unroll
        for (int part = 0; part < 16; ++part) { t += sa[part * 32 + tid]; b += sa[512 + part * 32 + tid]; }
        sa[1024 + tid] = t; sa[1056 + tid] = b; }
    __syncthreads();
    if (tid == 0) { int acc = 0; for (int e = 0; e < NE; ++e) { sa[1088 + e] = acc; const int nb = (sa[1024 + e] + 255) / 256;
            if (wg == 0) { for (int b = 0; b < nb; ++b) ctl[CW_BLKE + acc / 256 + b] = (unsigned)e; }
            acc += nb * 256; }
        if (wg == 0) ctl[CW_NBLK] = (unsigned)(acc / 256); }
    __syncthreads();
    if (tid < 256) { const int a = wg * 256 + tid, tok = a >> 2, e = topi[a], d = sa[1088 + e] + sa[1056 + e] + lrank[a];
        dest[a] = d; rowtok[d] = tok; rowscale[d] = rstd[tok]; }
    {   const int e = wg & 31, first = sa[1088 + e] + sa[1024 + e], last = sa[1088 + e] + ((sa[1024 + e] + 255) / 256) * 256;
        for (int row = first + (wg >> 5) * 512 + tid; row < last; row += (G >> 5) * 512) { rowtok[row] = T; rowscale[row] = 0.f; } }
}
__device__ __forceinline__ void combine_phase(const bf16_t* h, const unsigned char* y, const int* dest, const float* gate, float* out, int wg, int G) {
    const int tid = tid_opaque(), wave = tid >> 6, lane = tid & 63;
    for (int row = wg * NWAVES + wave; row < T; row += G * NWAVES) {
        int d[4]; float g[4];
#pragma unroll
        for (int k = 0; k < 4; ++k) { d[k] = dest[row * 4 + k]; g[k] = gate[row * 4 + k]; }
#pragma unroll
        for (int j = 0; j < 4; ++j) {
            const int c = (64 * j + lane) * 8;
            const u32x4 hw = *(const u32x4*)(h + (size_t)row * D + c);
            float o[8]; unpack8(hw, o);
#pragma unroll
            for (int k = 0; k < 4; ++k) { const u32x2 w = *(const u32x2*)(y + (size_t)d[k] * D + c); const float gk = g[k] * (1.0f / Y_SCALE);
                const pg8::f32v2_t p0 = __builtin_amdgcn_cvt_pk_f32_fp8((int)w.x, false), p1 = __builtin_amdgcn_cvt_pk_f32_fp8((int)w.x, true), p2 = __builtin_amdgcn_cvt_pk_f32_fp8((int)w.y, false), p3 = __builtin_amdgcn_cvt_pk_f32_fp8((int)w.y, true);
                o[0] += gk * p0[0]; o[1] += gk * p0[1]; o[2] += gk * p1[0]; o[3] += gk * p1[1]; o[4] += gk * p2[0]; o[5] += gk * p2[1]; o[6] += gk * p3[0]; o[7] += gk * p3[1]; }
            __builtin_nontemporal_store(((f32x4){o[0], o[1], o[2], o[3]}), (f32x4*)(out + (size_t)row * D + c)); __builtin_nontemporal_store(((f32x4){o[4], o[5], o[6], o[7]}), (f32x4*)(out + (size_t)row * D + c + 4));
        }
    }
}

__global__ void __launch_bounds__(512, 2) mega_fwd(Ptrs p) {
    extern __shared__ __attribute__((aligned(16))) unsigned char lds_raw[];
    LAS unsigned char* lds = (LAS unsigned char*)lds_raw;
    const int tid = tid_opaque(), wg = (int)blockIdx.x, G = (int)gridDim.x;
    unsigned char* ws = p.ws;
    unsigned* ctl = (unsigned*)(ws + WS_CTL);
    bf16_t *winT = (bf16_t*)(ws + WS_WINT), *woutT = (bf16_t*)(ws + WS_WOUTT); unsigned char *wguT = ws + WS_WGUT, *wdT = ws + WS_WDT;
    bf16_t *xn = (bf16_t*)(ws + WS_XN), *proj = (bf16_t*)(ws + WS_PROJ), *mixed = (bf16_t*)(ws + WS_MIXED);
    unsigned char *u = ws + WS_U, *xg = ws + WS_XG, *act = ws + WS_ACT, *y = ws + WS_Y;
    float *beta = (float*)(ws + WS_BETA), *gdec = (float*)(ws + WS_GDEC), *gate = (float*)(ws + WS_GATE); bf16_t* h = (bf16_t*)(ws + WS_H);
    int *topi = (int*)(ws + WS_TOPI), *dest = (int*)(ws + WS_DEST), *lrank = (int*)(ws + WS_LRANK), *cnt = (int*)(ws + WS_CNT); float* rowscale = (float*)(ws + WS_ROWTOK);
    int* rowtok = (int*)(ws + WS_RTOK);
    float *WB = (float*)(ws + WS_WB), *rstd = (float*)(ws + WS_RSTD), *xsc = (float*)(ws + WS_XS), *wsc = (float*)(ws + WS_WSC);
    bf16_t *NEGW = (bf16_t*)(ws + WS_NEGW), *QG = (bf16_t*)(ws + WS_QG), *KDT = (bf16_t*)(ws + WS_KDT), *UT = (bf16_t*)(ws + WS_UT), *AM = (bf16_t*)(ws + WS_AM); float* GLAST = (float*)(ws + WS_GLAST);

    if (tid < 4) ((LAS unsigned*)(lds + XB_OFF))[tid] = 0u;
    __syncthreads();
    XcdBarrier bar = xcd_barrier_post(ctl, (volatile LAS unsigned*)(lds + XB_OFF));

    {
    win8_phase(lds, p.w_in, (unsigned char*)winT, wsc, D, INW, INP, wg, G);
    wT_phase<0>(lds, p.w_out, woutT, D, D, D, 1, wg, G);
    wT8_phase<1>(lds, p.w_gate_up, wguT, D, 4096, NE, ctl + CW_TILEQ);
    wT8_phase<0>(lds, p.w_down, wdT, FF, D, NE, ctl + CW_TILEQ + 64);
    rms8_phase(p.x, p.attn_norm_w, (unsigned char*)xn, xsc, 1e-5f, wg, G);
    wb_phase(p.ffn_norm_w, p.w_router, WB, wg, G);
    xcd_barrier(bar); }
    {   pg8::Gemm g{xn, winT, 0, D, 0}; pg8::EpiInProj E{proj, beta, gdec, p.a_log, p.dt_bias, xsc, wsc};
        pg8::StaticOrder S; S.init(T / 256, INP / 256, G, wg);
        pg8::gemm_phase<pg8::EpiInProj, pg8::StaticOrder, true, false, true>(lds, g, S, E);
    xcd_barrier(bar); }
    {
    constexpr int NSPLIT = 20, ATT1 = 192, NSCAN = BATCH * 8;
#pragma unroll 1
    for (int part = 0; part < 2; ++part) {
        if (part == 1 && wg < NSCAN) break;
        gdn::prep_phase(lds, proj, beta, gdec, p.conv_w, NEGW, QG, KDT, AM, UT, GLAST, part ? NSPLIT : 0, part ? 32 - NSPLIT : NSPLIT, part ? wg - NSCAN : wg, part ? G - NSCAN : G);
        if (part == 0) xcd_barrier(bar);
    }
    if (wg < NSCAN) gdn::scan_phase(lds, NEGW, QG, KDT, AM, UT, GLAST, proj, p.dn_norm_w, mixed, wg, NSPLIT, [&]() { xcd_barrier(bar); });
    else {
#pragma unroll 1
        for (int part = 0; part < 2; ++part) {
            att::attn_phase(lds, proj, p.q_norm_w, p.k_norm_w, p.sinks, mixed, part ? ATT1 : 0, part ? att::NITEMS : ATT1, wg - NSCAN, G - NSCAN);
            if (part == 0) xcd_barrier(bar);
        }
    }
    xcd_barrier(bar); }
    {   pg8::Gemm g{mixed, woutT, 0, D, 0}; pg8::EpiOutProj E{p.x, h};
        pg8::StaticOrder S; S.init(T / 256, D / 256, G, wg);
        pg8::gemm_phase<pg8::EpiOutProj, pg8::StaticOrder, true>(lds, g, S, E);
    xcd_barrier(bar); }
    {
    router_phase(lds, h, p.ffn_norm_w, WB, p.b_router, u, rstd, topi, gate, lrank, cnt, wg, G, true);
    xcd_barrier(bar); }
    {
    place_scatter_phase(lds, cnt, topi, lrank, rstd, rowtok, rowscale, dest, ctl, wg, G);
    xcd_barrier(bar); }
    {   pg8::Gemm g{u, wguT, (size_t)4096 * D, D, 0}; pg8::EpiSwiGLU E{act, p.b_gate_up, rowscale};
        pg8::MoeOrder S; S.init((int)xb_ld(&ctl[CW_NBLK]), 4096 / 256, G, wg); S.blke = (const int*)(ctl + CW_BLKE); S.rowtok = rowtok;
        pg8::gemm_phase<pg8::EpiSwiGLU, pg8::MoeOrder, true, true, false, true>(lds, g, S, E);
    xcd_barrier(bar); }
    {   pg8::Gemm g{act, wdT, (size_t)D * FF, FF, 0}; pg8::EpiDown E{y, p.b_down};
        pg8::MoeOrder S; S.init((int)xb_ld(&ctl[CW_NBLK]), D / 256, G, wg); S.blke = (const int*)(ctl + CW_BLKE); S.rowtok = rowtok;
        pg8::gemm_phase<pg8::EpiDown, pg8::MoeOrder, true, true>(lds, g, S, E);
    xcd_barrier(bar); }
    combine_phase(h, y, dest, gate, p.out, wg, G);
}

extern "C" void kernel_launch(void* const* d_in, const int* in_sizes, int n_in, void* d_out, int out_size, void* d_ws, size_t ws_size, hipStream_t stream) {
    static int grid = 0;
    if (grid == 0) {
        if (n_in != 18 || in_sizes[0] != T * D || out_size != T * D || ws_size < WS_END) { fprintf(stderr, "kernel_launch: unexpected shapes (n_in %d, in0 %d, out %d, ws %zu < %zu)\n", n_in, n_in > 0 ? in_sizes[0] : -1, out_size, ws_size, (size_t)WS_END); grid = -1; return; }
        int dev = 0, cus = 0, per_cu = 0;
        if (hipGetDevice(&dev) != hipSuccess || hipDeviceGetAttribute(&cus, hipDeviceAttributeMultiprocessorCount, dev) != hipSuccess) { grid = -1; return; }
        if (hipFuncSetAttribute((const void*)mega_fwd, hipFuncAttributeMaxDynamicSharedMemorySize, LDS_BYTES) != hipSuccess) { fprintf(stderr, "kernel_launch: hipFuncSetAttribute failed\n"); grid = -1; return; }
        if (hipOccupancyMaxActiveBlocksPerMultiprocessor(&per_cu, (const void*)mega_fwd, 512, LDS_BYTES) != hipSuccess || per_cu < 1) { fprintf(stderr, "kernel_launch: occupancy query says %d\n", per_cu); grid = -1; (void)hipGetLastError(); return; }
        grid = cus;
        if (grid != 256 || T != 64 * grid) { fprintf(stderr, "kernel_launch: built for a 256-CU device (got %d)\n", grid); grid = -1; return; }
    }
    if (grid < 0) return;
    Ptrs p{};
    const float** pf = (const float**)&p;
    for (int i = 0; i < 18; ++i) pf[i] = (const float*)d_in[i];
    p.out = (float*)d_out; p.ws = (unsigned char*)d_ws;
    (void)hipMemsetAsync((unsigned char*)d_ws + WS_CTL, 0, 128u << 10, stream);
    hipLaunchKernelGGL(mega_fwd, dim3(grid), dim3(512), LDS_BYTES, stream, p);
}
```

```cpp
#include <hip/hip_runtime.h>
#include <cstdio>
#include <cstdint>

constexpr int BATCH = 8, SEQ = 2048, T = BATCH * SEQ, D = 2048;
constexpr int INW = 5648, INP = 5888, PROJW = 5632;
constexpr int C_AQ = 0, C_AK = 1024, C_AV = 1280, C_DQ = 1536, C_DK = 2560, C_DV = 3584, C_DZ = 4608;
constexpr int NE = 32, TOPK = 4, FF = 2048;
constexpr int NASSIGN = T * TOPK;
constexpr int MAXBLK = NASSIGN / 256 + NE;
constexpr int P = MAXBLK * 256;

typedef unsigned short bf16_t;
typedef short bf16x8 __attribute__((ext_vector_type(8)));
typedef float f32x4 __attribute__((ext_vector_type(4)));
typedef unsigned u32x4 __attribute__((ext_vector_type(4)));
typedef unsigned u32x2 __attribute__((ext_vector_type(2)));
typedef int v4i_t __attribute__((ext_vector_type(4)));
typedef int v8i_t __attribute__((ext_vector_type(8)));

constexpr size_t al256(size_t x) { return (x + 255) & ~(size_t)255; }
constexpr size_t WS_CTL = 0, CTL_BYTES = 1u << 20;
constexpr size_t WS_WINT = WS_CTL + CTL_BYTES;
constexpr size_t WS_WOUTT = WS_WINT + al256((size_t)INP * D * 2);
constexpr size_t WS_WGUT = WS_WOUTT + al256((size_t)D * D * 2);
constexpr size_t WS_WDT = WS_WGUT + al256((size_t)NE * 4096 * D * 2);
constexpr size_t WS_XN = WS_WDT + al256((size_t)NE * D * FF * 2);
constexpr size_t WS_PROJ = WS_XN + al256((size_t)T * D * 2);
constexpr size_t WS_BETA = WS_PROJ + al256((size_t)T * PROJW * 2);
constexpr size_t WS_GDEC = WS_BETA + al256((size_t)T * 8 * 4);
constexpr size_t WS_MIXED = WS_GDEC + al256((size_t)T * 8 * 4);
constexpr size_t WS_H = WS_MIXED + al256((size_t)T * D * 2);
constexpr size_t WS_U = WS_H + al256((size_t)T * D * 4);
constexpr size_t WS_TOPI = WS_U + al256((size_t)(T + 1) * D * 2);
constexpr size_t WS_GATE = WS_TOPI + al256((size_t)T * 4 * 4);
constexpr size_t WS_DEST = WS_GATE + al256((size_t)T * 4 * 4);
constexpr size_t WS_ROWTOK = WS_DEST + al256((size_t)T * 4 * 4);
constexpr size_t WS_XG = WS_ROWTOK + al256((size_t)P * 4);
constexpr size_t WS_ACT = WS_XG + al256((size_t)P * D * 2);
constexpr size_t WS_Y = WS_ACT + al256((size_t)P * FF * 2);
constexpr size_t WS_QN = WS_Y + al256((size_t)P * D * 2);
constexpr size_t WS_KN = WS_QN + al256((size_t)T * 1024 * 4);
constexpr size_t WS_NEGW = WS_KN + al256((size_t)T * 256 * 4);
constexpr size_t WS_QG = WS_NEGW + (size_t)2048 * 8192 * 2;
constexpr size_t WS_KDT = WS_QG + (size_t)2048 * 8192 * 2;
constexpr size_t WS_UT = WS_KDT + (size_t)2048 * 8192 * 2;
constexpr size_t WS_AM = WS_UT + (size_t)2048 * 8192 * 2;
constexpr size_t WS_GLAST = WS_AM + (size_t)2048 * 4096 * 2;
constexpr size_t WS_WB = WS_GLAST + al256(2048 * 4);
constexpr size_t WS_RSTD = WS_WB + (size_t)D * NE * 4;
constexpr size_t WS_LRANK = WS_RSTD + al256((size_t)(T + 1) * 4);
constexpr size_t WS_CNT = WS_LRANK + al256((size_t)T * 4 * 4);
constexpr size_t WS_RTOK = WS_CNT + al256(256 * 32 * 4);
constexpr size_t WS_XS = WS_RTOK + al256((size_t)P * 4);
constexpr size_t WS_WSC = WS_XS + al256((size_t)T * 4);
constexpr size_t WS_END = WS_WSC + al256(INP * 4);
constexpr int CW_COUNT = 8192;
constexpr int CW_CURSOR = 8192 + 64;
constexpr int CW_PSTART = 8192 + 128;
constexpr int CW_NBLK = 8192 + 192;
constexpr int CW_BLKE = 8192 + 256;
constexpr int CW_TILEQ = 16384;

__device__ __forceinline__ bf16_t f2bf(float f) { unsigned u = __float_as_uint(f); u += 0x7FFFu + ((u >> 16) & 1u); return (bf16_t)(u >> 16); }
__device__ __forceinline__ float bf2f(bf16_t b) { return __uint_as_float(((unsigned)b) << 16); }
__device__ __forceinline__ unsigned pk2(float lo, float hi) { return (unsigned)f2bf(lo) | ((unsigned)f2bf(hi) << 16); }
__device__ __forceinline__ float wave_sum(float v) {
#pragma unroll
    for (int o = 1; o < 64; o <<= 1) v += __shfl_xor(v, o);
    return v;
}
constexpr float U_SCALE = 16.0f, W_SCALE = 64.0f, ACT_SCALE = 8.0f, Y_SCALE = 16.0f;
__device__ __forceinline__ float clamp448(float x) { return fminf(fmaxf(x, -448.0f), 448.0f); }
__device__ __forceinline__ unsigned pk4_fp8(float a, float b, float c, float d) {
    int w = __builtin_amdgcn_cvt_pk_fp8_f32(clamp448(a), clamp448(b), 0, false); w = __builtin_amdgcn_cvt_pk_fp8_f32(clamp448(c), clamp448(d), w, true); return (unsigned)w; }
__device__ __forceinline__ int tid_opaque() { int t = (int)threadIdx.x; asm volatile("" : "+v"(t)); return t; }
__device__ __forceinline__ float sigmoidf_(float x) { return __builtin_amdgcn_rcpf(1.0f + __builtin_amdgcn_exp2f(-1.4426950408889634f * x)); }
__device__ __forceinline__ float siluf_(float x) { return x * __builtin_amdgcn_rcpf(1.0f + __builtin_amdgcn_exp2f(-1.4426950408889634f * x)); }
__device__ __forceinline__ float softplusf_(float x) { return x > 20.f ? x : log1pf(__expf(x)); }

namespace pg8 {
#define PG8_LAS __attribute__((address_space(3)))
constexpr int BM = 256, BK = 64, HALF = 128, HTB = HALF * BK * 2, STAGE_BYTES = 8 * HTB, NXCD = 8, WGM = 8;
__host__ __device__ __forceinline__ int lds_byte(int r, int c) { const int st = (r >> 4) * 2 + (c >> 5), rr = r & 15, cc = c & 31, ob = rr * 64 + cc * 2; return st * 1024 + (ob ^ (((ob >> 9) & 1) << 5)); }
__host__ __device__ __forceinline__ void stage_rc(int b, int& R, int& C) { const int st = b / 1024, sb = b % 1024, swz = sb ^ (((sb >> 9) & 1) << 5); R = (st >> 1) * 16 + swz / 64; C = (st & 1) * 32 + (swz % 64) / 2; }
__host__ __device__ __forceinline__ int perm32(int rho) { const int n = rho >> 4, i = rho & 15; return 8 * (i >> 2) + 4 * n + (i & 3); }

struct Unit { int pm, pn, pe; };
struct Gemm { const void* A; const void* Bt; size_t bstride; int K; int pad; };

struct StaticOrder {
    int nM, nN, nwg, G, c;
    __device__ void init(int nM_, int nN_, int G_, int c_) { nM = nM_; nN = nN_; nwg = nM * nN; G = G_; c = c_; }
    __device__ bool next(int i, Unit& u) const {
        const long L = (long)i * G + c; if (L >= nwg) return false;
        int wgid = (int)L; { const int q = nwg / NXCD, r = nwg % NXCD, xcd = wgid % NXCD, off = wgid / NXCD; wgid = (xcd < r ? xcd * (q + 1) : r * (q + 1) + (xcd - r) * q) + off; }
        const int nig = WGM * nN, gid = wgid / nig, fm = gid * WGM, gsz = (nM - fm) < WGM ? (nM - fm) : WGM;
        u.pm = fm + ((wgid % nig) % gsz); u.pn = (wgid % nig) / gsz; u.pe = 0; return true;
    }
};
struct MoeOrder : StaticOrder {
    const int* blke; const int* rowtok;
    __device__ bool next(int i, Unit& u) const { if (!StaticOrder::next(i, u)) return false; u.pe = __hip_atomic_load(blke + u.pm, __ATOMIC_RELAXED, __HIP_MEMORY_SCOPE_AGENT); return true; }
};

typedef __bf16 bf16v2_t __attribute__((ext_vector_type(2)));
typedef float f32v2_t __attribute__((ext_vector_type(2)));
__device__ __forceinline__ unsigned cvt_pk_bf16(float lo, float hi) { const f32v2_t v = {lo, hi}; return __builtin_bit_cast(unsigned, __builtin_convertvector(v, bf16v2_t)); }

template <class Epi, class Sched, bool ALIGN_EPI = true, bool FP8 = false, bool I8 = false, bool GATHER = false>
__device__ __forceinline__ void gemm_phase(PG8_LAS unsigned char* lds, const Gemm g, const Sched& S, const Epi& E) {
    const int tid = tid_opaque(), wid = __builtin_amdgcn_readfirstlane(tid >> 6), lane = tid & 63, wr = wid >> 2, wc = wid & 3, fr = lane & 15, fq = lane >> 4;
    const int pitch = (FP8 || I8) ? g.K : 2 * g.K, nt = pitch / 128;
#define PG8_G(r) (((((r) >> 1) & 7)) ^ (((((r) >> 1) & 7) & 2) << 1))
    unsigned voffA[2], voffB[2];
#pragma unroll
    for (int i = 0; i < 2; ++i) { const int o = tid * 16 + i * 8192, R = o >> 7, cp = (o >> 4) & 7, CB = (cp ^ PG8_G(R & 15)) * 16;
        const int Rb = Epi::PERM ? ((R & ~31) + perm32(R & 31)) : R;
        voffA[i] = (unsigned)(R * pitch + CB); voffB[i] = (unsigned)(Rb * pitch + CB); }
    const size_t kstep = (size_t)128;
    const size_t hstep = (size_t)HALF * pitch;
    const size_t tstep = 2 * hstep;
    const unsigned ldsw = (unsigned)wid * 1024u;
    const int c0 = FP8 ? 2 * fq : fq, c1 = FP8 ? 2 * fq + 1 : 4 + fq, gf = PG8_G(fr);
    unsigned ldsA0_u = (unsigned)(size_t)lds + (unsigned)((wr * 64 + fr) * 128 + ((c0 ^ gf) * 16)), ldsA1_u = (unsigned)(size_t)lds + (unsigned)((wr * 64 + fr) * 128 + ((c1 ^ gf) * 16));
    unsigned ldsB0_u = (unsigned)(size_t)lds + 65536u + (unsigned)((wc * 32 + fr) * 128 + ((c0 ^ gf) * 16)), ldsB1_u = (unsigned)(size_t)lds + 65536u + (unsigned)((wc * 32 + fr) * 128 + ((c1 ^ gf) * 16));
    asm volatile("" : "+v"(ldsA0_u), "+v"(ldsA1_u), "+v"(ldsB0_u), "+v"(ldsB1_u));
    const PG8_LAS unsigned char* ldsA0 = (const PG8_LAS unsigned char*)(size_t)ldsA0_u; const PG8_LAS unsigned char* ldsA1 = (const PG8_LAS unsigned char*)(size_t)ldsA1_u;
    const PG8_LAS unsigned char* ldsB0 = (const PG8_LAS unsigned char*)(size_t)ldsB0_u; const PG8_LAS unsigned char* ldsB1 = (const PG8_LAS unsigned char*)(size_t)ldsB1_u;
#undef PG8_G
#define PG8_SA(b, h) (((b) * 2 + (h)) * HTB)
#define PG8_SB(b, h) ((4 + (b) * 2 + (h)) * HTB)
#define PG8_STAGE(bufoff, gbase, voff) do { _Pragma("unroll") for (int _i = 0; _i < 2; ++_i) \
        __builtin_amdgcn_global_load_lds((const unsigned*)((const char*)(gbase) + (voff)[_i]), (PG8_LAS unsigned*)(lds + (bufoff) + ldsw + _i * 8192), 16, 0, 0); } while (0)
#define PG8_LD8(p0, p1, base) __builtin_shufflevector(*(const PG8_LAS v4i_t*)((p0) + (base)), *(const PG8_LAS v4i_t*)((p1) + (base)), 0, 1, 2, 3, 4, 5, 6, 7)
#define PG8_LDA(dst, b, h) do { if constexpr (FP8) { _Pragma("unroll") for (int m = 0; m < 4; ++m) dst##8[m] = PG8_LD8(ldsA0, ldsA1, PG8_SA(b, h) + m * 2048); } \
        else { _Pragma("unroll") for (int m = 0; m < 4; ++m) { dst[m][0] = *(const PG8_LAS bf16x8*)(ldsA0 + PG8_SA(b, h) + m * 2048); dst[m][1] = *(const PG8_LAS bf16x8*)(ldsA1 + PG8_SA(b, h) + m * 2048); } } } while (0)
#define PG8_LDB(dst, b, h) do { if constexpr (FP8) { _Pragma("unroll") for (int n = 0; n < 2; ++n) dst##8[n] = PG8_LD8(ldsB0, ldsB1, PG8_SB(b, h) - 65536 + n * 2048); } \
        else { _Pragma("unroll") for (int n = 0; n < 2; ++n) { dst[n][0] = *(const PG8_LAS bf16x8*)(ldsB0 + PG8_SB(b, h) - 65536 + n * 2048); dst[n][1] = *(const PG8_LAS bf16x8*)(ldsB1 + PG8_SB(b, h) - 65536 + n * 2048); } } } while (0)
#define PG8_MMA(ai, bj, At, Bt) do { __builtin_amdgcn_s_setprio(1); \
        if constexpr (FP8) { _Pragma("unroll") for (int m = 0; m < 4; ++m) _Pragma("unroll") for (int n = 0; n < 2; ++n) \
            asm volatile("v_mfma_scale_f32_16x16x128_f8f6f4 %0, %1, %2, %0, %3, %3 op_sel_hi:[0,0,0]" : "+v"(acc[ai][bj][m][n]) : "v"(Bt##8[n]), "v"(At##8[m]), "v"(one_scale)); } \
        else if constexpr (I8) { _Pragma("unroll") for (int m = 0; m < 4; ++m) _Pragma("unroll") for (int n = 0; n < 2; ++n) _Pragma("unroll") for (int k = 0; k < 2; ++k) \
            acc[ai][bj][m][n] = __builtin_bit_cast(f32x4, __builtin_amdgcn_mfma_i32_16x16x64_i8(__builtin_bit_cast(v4i_t, Bt[n][k]), __builtin_bit_cast(v4i_t, At[m][k]), __builtin_bit_cast(v4i_t, acc[ai][bj][m][n]), 0, 0, 0)); } \
        else { _Pragma("unroll") for (int m = 0; m < 4; ++m) _Pragma("unroll") for (int n = 0; n < 2; ++n) _Pragma("unroll") for (int k = 0; k < 2; ++k) \
            acc[ai][bj][m][n] = __builtin_amdgcn_mfma_f32_16x16x32_bf16(Bt[n][k], At[m][k], acc[ai][bj][m][n], 0, 0, 0); } \
        __builtin_amdgcn_s_setprio(0); } while (0)
#define PG8_WAIT_V(n) asm volatile("s_waitcnt vmcnt(" #n ")" ::: "memory")
#define PG8_WAIT_L(n) asm volatile("s_waitcnt lgkmcnt(" #n ")" ::: "memory")
#define PG8_BAR __builtin_amdgcn_s_barrier()
#define PG8_SCHED __builtin_amdgcn_sched_barrier(0)
    const int one_scale = 0x7F7F7F7F;
    Unit cur, nxt; int ui = 0;
    if (!S.next(0, cur)) return;
    f32x4 acc[2][2][4][2];
#pragma unroll
    for (int a = 0; a < 2; ++a)
#pragma unroll
        for (int b = 0; b < 2; ++b)
#pragma unroll
            for (int m = 0; m < 4; ++m)
#pragma unroll
                for (int n = 0; n < 2; ++n) acc[a][b][m][n] = (f32x4){0.f, 0.f, 0.f, 0.f};
    bf16x8 At[4][2], B0[2][2], B1[2][2]; v8i_t At8[4], B08[2], B18[2];
    unsigned vgC[2][2], vgN[2][2];
    PG8_LAS unsigned short* gtab = (PG8_LAS unsigned short*)(lds + STAGE_BYTES);
    const unsigned gcb = (unsigned)(((tid & 7) ^ ((((tid >> 4) & 7)) ^ (((((tid >> 4) & 7)) & 2) << 1))) * 16);
#define PG8_GLOAD(dst, ui_) do { _Pragma("unroll") for (int h_ = 0; h_ < 2; ++h_) _Pragma("unroll") for (int i_ = 0; i_ < 2; ++i_) \
        dst[h_][i_] = (unsigned)gtab[(ui_) * 256 + h_ * 128 + i_ * 64 + (tid >> 3)] * (unsigned)pitch + gcb; } while (0)
    if constexpr (GATHER) {
        Unit uu;
        for (int i = 0; S.next(i, uu); ++i) if (tid < 256) gtab[i * 256 + tid] = (unsigned short)S.rowtok[uu.pm * 256 + tid];
        __syncthreads();
        PG8_GLOAD(vgC, 0);
    }
    const char* cA = GATHER ? (const char*)g.A : (const char*)g.A + (size_t)cur.pm * tstep; const char* cB = (const char*)g.Bt + (size_t)cur.pe * g.bstride + (size_t)cur.pn * tstep;
#define PG8_STAGE_A(b, gb) do { if constexpr (GATHER) { PG8_STAGE(PG8_SA(b, 0), gb, vgC[0]); PG8_STAGE(PG8_SA(b, 1), gb, vgC[1]); } \
        else { PG8_STAGE(PG8_SA(b, 0), gb, voffA); PG8_STAGE(PG8_SA(b, 1), (gb) + hstep, voffA); } } while (0)
    PG8_STAGE(PG8_SB(0, 0), cB, voffB); PG8_STAGE(PG8_SB(0, 1), cB + hstep, voffB); PG8_STAGE_A(0, cA);
    if (wr == 1) PG8_BAR;
    PG8_WAIT_V(2); PG8_BAR;
    PG8_STAGE(PG8_SB(1, 0), cB + kstep, voffB); PG8_STAGE(PG8_SB(1, 1), cB + hstep + kstep, voffB);
    PG8_WAIT_V(4); PG8_BAR;
    for (;;) {
        const bool has_next = S.next(ui + 1, nxt);
        const char* nA = GATHER ? cA : (has_next ? (const char*)g.A + (size_t)nxt.pm * tstep : cA);
        const char* nB = has_next ? (const char*)g.Bt + (size_t)nxt.pe * g.bstride + (size_t)nxt.pn * tstep : cB;
        for (int t = 0; t < nt; t += 2) {
            const bool last = (t == nt - 2);
            const char* a1 = cA + (size_t)(t + 1) * kstep;
            const char* a2 = last ? nA : cA + (size_t)(t + 2) * kstep; const char* b2 = last ? nB : cB + (size_t)(t + 2) * kstep;
            const char* b3 = b2 + kstep;
            if constexpr (GATHER) { if (last) PG8_GLOAD(vgN, has_next ? ui + 1 : ui); }
            PG8_LDB(B0, 0, 0); PG8_LDB(B1, 0, 1); PG8_SCHED; PG8_LDA(At, 0, 0); PG8_STAGE_A(1, a1);
            if constexpr (GATHER) { if (last) {
#pragma unroll
                for (int h_ = 0; h_ < 2; ++h_) { vgC[h_][0] = vgN[h_][0]; vgC[h_][1] = vgN[h_][1]; } } }
            PG8_WAIT_V(8); PG8_WAIT_L(0); PG8_BAR; PG8_MMA(0, 0, At, B0); PG8_MMA(0, 1, At, B1); PG8_BAR; PG8_SCHED;
            PG8_LDA(At, 0, 1); PG8_STAGE(PG8_SB(0, 0), b2, voffB); PG8_STAGE(PG8_SB(0, 1), b2 + hstep, voffB);
            PG8_WAIT_V(6); PG8_WAIT_L(0); PG8_BAR; PG8_MMA(1, 0, At, B0); PG8_MMA(1, 1, At, B1); PG8_BAR; PG8_SCHED;
            PG8_LDB(B0, 1, 0); PG8_LDB(B1, 1, 1); PG8_SCHED; PG8_LDA(At, 1, 0); PG8_STAGE_A(0, a2);
            PG8_WAIT_V(8); PG8_WAIT_L(0); PG8_BAR; PG8_MMA(0, 0, At, B0); PG8_MMA(0, 1, At, B1); PG8_BAR; PG8_SCHED;
            PG8_LDA(At, 1, 1); PG8_STAGE(PG8_SB(1, 0), b3, voffB); PG8_STAGE(PG8_SB(1, 1), b3 + hstep, voffB);
            PG8_WAIT_V(6); PG8_WAIT_L(0); PG8_BAR; PG8_MMA(1, 0, At, B0); PG8_MMA(1, 1, At, B1); PG8_BAR; PG8_SCHED;
        }
        if constexpr (ALIGN_EPI) { if (wr == 0) PG8_BAR; }
        if constexpr (FP8) asm volatile("s_nop 15\n\ts_nop 15" ::: "memory");
        E(acc, cur, wr, wc, fr, fq);
        if (!has_next) break;
#pragma unroll
        for (int a = 0; a < 2; ++a)
#pragma unroll
            for (int b = 0; b < 2; ++b)
#pragma unroll
                for (int m = 0; m < 4; ++m)
#pragma unroll
                    for (int n = 0; n < 2; ++n) acc[a][b][m][n] = (f32x4){0.f, 0.f, 0.f, 0.f};
        cur = nxt; cA = nA; cB = nB; ++ui;
        if constexpr (ALIGN_EPI) { if (wr == 1) PG8_BAR; }
    }
    PG8_WAIT_V(0);
    if constexpr (!ALIGN_EPI) { if (wr == 0) PG8_BAR; }
    PG8_BAR;
#undef PG8_SA
#undef PG8_SB
#undef PG8_STAGE
#undef PG8_STAGE_A
#undef PG8_GLOAD
#undef PG8_LDA
#undef PG8_LDB
#undef PG8_MMA
#undef PG8_LD8
#undef PG8_WAIT_V
#undef PG8_WAIT_L
#undef PG8_BAR
#undef PG8_SCHED
}

struct EpiInProj {
    static constexpr bool PERM = true;
    bf16_t* proj; float* beta; float* gdec; const float* a_log; const float* dt_bias; const float* xs; const float* wsc;
    __device__ __forceinline__ void operator()(const f32x4 (&acc)[2][2][4][2], const Unit& u, int wr, int wc, int fr, int fq) const {
        const int row0 = u.pm * BM + wr * 64 + fr;
        float rsv[2][4];
#pragma unroll
        for (int ai = 0; ai < 2; ++ai)
#pragma unroll
            for (int m = 0; m < 4; ++m) rsv[ai][m] = xs[row0 + ai * HALF + m * 16];
        if (u.pn < PROJW / BM) {
            const int col0 = u.pn * BM + wc * 32 + 8 * fq;
            f32x4 cs[2][2];
#pragma unroll
            for (int bj = 0; bj < 2; ++bj)
#pragma unroll
                for (int n = 0; n < 2; ++n) cs[bj][n] = *(const f32x4*)(wsc + col0 + bj * HALF + 4 * n);
#pragma unroll
            for (int ai = 0; ai < 2; ++ai)
#pragma unroll
                for (int m = 0; m < 4; ++m) { const int row = row0 + ai * HALF + m * 16; const float rs = rsv[ai][m]; bf16_t* rowp = proj + (size_t)row * PROJW + col0;
#pragma unroll
                    for (int bj = 0; bj < 2; ++bj) { const f32x4 v0 = __builtin_convertvector(__builtin_bit_cast(v4i_t, acc[ai][bj][m][0]), f32x4) * rs * cs[bj][0], v1 = __builtin_convertvector(__builtin_bit_cast(v4i_t, acc[ai][bj][m][1]), f32x4) * rs * cs[bj][1];
                        u32x4 w; w.x = cvt_pk_bf16(v0[0], v0[1]); w.y = cvt_pk_bf16(v0[2], v0[3]); w.z = cvt_pk_bf16(v1[0], v1[1]); w.w = cvt_pk_bf16(v1[2], v1[3]);
                        *(u32x4*)(rowp + bj * HALF) = w; } }
        } else if (wc == 0 && fq < 2) {
            const int colb = u.pn * BM + 8 * fq;
#pragma unroll
            for (int ai = 0; ai < 2; ++ai)
#pragma unroll
                for (int m = 0; m < 4; ++m) { const int row = row0 + ai * HALF + m * 16; const float rs = rsv[ai][m];
#pragma unroll
                    for (int n = 0; n < 2; ++n)
#pragma unroll
                        for (int j = 0; j < 4; ++j) { const int hh = 4 * n + j; const float v = (float)__builtin_bit_cast(v4i_t, acc[ai][0][m][n])[j] * rs * wsc[colb + hh];
                            if (fq == 0) beta[(size_t)row * 8 + hh] = sigmoidf_(v);
                            else gdec[(size_t)row * 8 + hh] = -__expf(a_log[hh]) * softplusf_(v + dt_bias[hh]); } }
        }
    }
};
struct EpiOutProj {
    static constexpr bool PERM = false;
    const float* x; bf16_t* h;
    __device__ __forceinline__ void operator()(const f32x4 (&acc)[2][2][4][2], const Unit& u, int wr, int wc, int fr, int fq) const {
        const int row0 = u.pm * BM + wr * 64 + fr, col0 = u.pn * BM + wc * 32 + 4 * fq;
#pragma unroll
        for (int ai = 0; ai < 2; ++ai) {
            f32x4 xv[4][2][2];
#pragma unroll
            for (int m = 0; m < 4; ++m)
#pragma unroll
                for (int bj = 0; bj < 2; ++bj)
#pragma unroll
                    for (int n = 0; n < 2; ++n) xv[m][bj][n] = *(const f32x4*)(x + (size_t)(row0 + ai * HALF + m * 16) * D + col0 + bj * HALF + n * 16);
#pragma unroll
            for (int m = 0; m < 4; ++m) { const size_t off = (size_t)(row0 + ai * HALF + m * 16) * D + col0;
#pragma unroll
                for (int bj = 0; bj < 2; ++bj)
#pragma unroll
                    for (int n = 0; n < 2; ++n) { const f32x4 v = xv[m][bj][n] + acc[ai][bj][m][n];
                        u32x2 w; w.x = cvt_pk_bf16(v[0], v[1]); w.y = cvt_pk_bf16(v[2], v[3]); *(u32x2*)(h + off + bj * HALF + n * 16) = w; } }
        }
    }
};
struct EpiSwiGLU {
    static constexpr bool PERM = true;
    unsigned char* act; const float* bgu; const float* rowscale;
    __device__ __forceinline__ void operator()(const f32x4 (&acc)[2][2][4][2], const Unit& u, int wr, int wc, int fr, int fq) const {
        const int row0 = u.pm * BM + wr * 64 + fr, col0 = u.pn * HALF + wc * 32 + 8 * fq;
        const float* bg = bgu + (size_t)u.pe * 4096 + col0;
        f32x4 bg0 = *(const f32x4*)(bg), bg1 = *(const f32x4*)(bg + 4), bl0 = *(const f32x4*)(bg + 2048), bl1 = *(const f32x4*)(bg + 2048 + 4);
        float rsv[2][4];
#pragma unroll
        for (int ai = 0; ai < 2; ++ai)
#pragma unroll
            for (int m = 0; m < 4; ++m) rsv[ai][m] = rowscale[row0 + ai * HALF + m * 16];
#pragma unroll
        for (int ai = 0; ai < 2; ++ai)
#pragma unroll
            for (int m = 0; m < 4; ++m) {
                const float SC = rsv[ai][m] * (1.0f / (U_SCALE * W_SCALE));
                f32x4 g0 = acc[ai][0][m][0] * SC + bg0, g1 = acc[ai][0][m][1] * SC + bg1, l0 = acc[ai][1][m][0] * SC + bl0, l1 = acc[ai][1][m][1] * SC + bl1;
                float o[8];
#pragma unroll
                for (int j = 0; j < 4; ++j) {
                    float a = fminf(g0[j], 7.0f), b = __builtin_amdgcn_fmed3f(l0[j], -7.0f, 7.0f); o[j] = a * __builtin_amdgcn_rcpf(1.0f + __builtin_amdgcn_exp2f(-2.4554669595930156f * a)) * (b * ACT_SCALE + ACT_SCALE);
                    float c = fminf(g1[j], 7.0f), d = __builtin_amdgcn_fmed3f(l1[j], -7.0f, 7.0f); o[4 + j] = c * __builtin_amdgcn_rcpf(1.0f + __builtin_amdgcn_exp2f(-2.4554669595930156f * c)) * (d * ACT_SCALE + ACT_SCALE); }
                u32x2 w; { int t0_ = __builtin_amdgcn_cvt_pk_fp8_f32(o[0], o[1], 0, false); t0_ = __builtin_amdgcn_cvt_pk_fp8_f32(o[2], o[3], t0_, true); int t1_ = __builtin_amdgcn_cvt_pk_fp8_f32(o[4], o[5], 0, false); t1_ = __builtin_amdgcn_cvt_pk_fp8_f32(o[6], o[7], t1_, true); w.x = (unsigned)t0_; w.y = (unsigned)t1_; }
                *(u32x2*)(act + (size_t)(row0 + ai * HALF + m * 16) * FF + col0) = w; }
    }
};
struct EpiDown {
    static constexpr bool PERM = true;
    unsigned char* y; const float* bd;
    __device__ __forceinline__ void operator()(const f32x4 (&acc)[2][2][4][2], const Unit& u, int wr, int wc, int fr, int fq) const {
        const int row0 = u.pm * BM + wr * 64 + fr, col0 = u.pn * BM + wc * 32 + 8 * fq;
        const float* bp = bd + (size_t)u.pe * D + col0;
        f32x4 bv[2][2];
#pragma unroll
        for (int bj = 0; bj < 2; ++bj)
#pragma unroll
            for (int n = 0; n < 2; ++n) bv[bj][n] = *(const f32x4*)(bp + bj * HALF + 4 * n) * Y_SCALE;
#pragma unroll
        for (int ai = 0; ai < 2; ++ai)
#pragma unroll
            for (int m = 0; m < 4; ++m) { unsigned char* rowp = y + (size_t)(row0 + ai * HALF + m * 16) * D + col0;
#pragma unroll
                for (int bj = 0; bj < 2; ++bj) { constexpr float SC = Y_SCALE / (ACT_SCALE * W_SCALE); const f32x4 v0 = acc[ai][bj][m][0] * SC + bv[bj][0], v1 = acc[ai][bj][m][1] * SC + bv[bj][1];
                    u32x2 w; w.x = pk4_fp8(v0[0], v0[1], v0[2], v0[3]); w.y = pk4_fp8(v1[0], v1[1], v1[2], v1[3]);
                    *(u32x2*)(rowp + bj * HALF) = w; } }
    }
};
}

struct Ptrs {
    const float *x, *attn_norm_w, *w_in, *q_norm_w, *k_norm_w, *sinks, *conv_w, *a_log, *dt_bias, *dn_norm_w, *w_out, *ffn_norm_w, *w_router, *b_router, *w_gate_up, *b_gate_up, *w_down, *b_down;
    float* out; unsigned char* ws;
};

#define LAS __attribute__((address_space(3)))
__device__ __forceinline__ bf16x8 pack8(float a0, float a1, float a2, float a3, float a4, float a5, float a6, float a7) {
    u32x4 w; w.x = pg8::cvt_pk_bf16(a0, a1); w.y = pg8::cvt_pk_bf16(a2, a3); w.z = pg8::cvt_pk_bf16(a4, a5); w.w = pg8::cvt_pk_bf16(a6, a7);
    return __builtin_bit_cast(bf16x8, w);
}
__device__ __forceinline__ void unpack8(const u32x4 w, float (&f)[8]) {
    f[0] = __uint_as_float(w.x << 16); f[1] = __uint_as_float(w.x & 0xffff0000u); f[2] = __uint_as_float(w.y << 16); f[3] = __uint_as_float(w.y & 0xffff0000u);
    f[4] = __uint_as_float(w.z << 16); f[5] = __uint_as_float(w.z & 0xffff0000u); f[6] = __uint_as_float(w.w << 16); f[7] = __uint_as_float(w.w & 0xffff0000u);
}
#define MFMA16(a, b, c) __builtin_amdgcn_mfma_f32_16x16x32_bf16((a), (b), (c), 0, 0, 0)

namespace att {
constexpr int KS_STRIDE = 144, VT_STRIDE = 528;
constexpr int KS_OFF = 0, VT_OFF = 256 * KS_STRIDE, LDS_BYTES = VT_OFF + 64 * VT_STRIDE;
constexpr int NITEMS = BATCH * 16 * 4;
__device__ __forceinline__ void attn_phase(LAS unsigned char* lds, const bf16_t* __restrict__ proj, const float* __restrict__ qw, const float* __restrict__ kw, const float* __restrict__ sinks,
                                           bf16_t* __restrict__ mixed, int lo, int hi, int first, int stride) {
    const int tid = tid_opaque(), w = __builtin_amdgcn_readfirstlane(tid >> 6), lane = tid & 63, qq = lane & 15, kq = lane >> 4;
    float mq = 0.f, mk = 0.f, ms = -1e30f;
    for (int d = 0; d < 64; ++d) { mq = fmaxf(mq, fabsf(qw[d])); mk = fmaxf(mk, fabsf(kw[d])); }
    for (int h = 0; h < 16; ++h) ms = fmaxf(ms, sinks[h]);
    const float L2E = 1.4426950408889634f;
    const float m02 = fmaxf(8.0f * mq * mk, ms) * L2E;
    for (int item = lo + first; item < hi; item += stride) {
        const int kvh = item & 3, qb = (item >> 2) & 15, b = item >> 6;
        const int h = kvh * 4 + (w >> 1), qhalf = w & 1;
        const long tok0 = (long)b * SEQ + (qb - 1) * 128;
        u32x4 qr0[4], qr1[4];
#pragma unroll
        for (int qt = 0; qt < 4; ++qt) { const bf16_t* rp = proj + ((size_t)b * SEQ + qb * 128 + qhalf * 64 + qt * 16 + qq) * PROJW + C_AQ + h * 64 + kq * 8; qr0[qt] = *(const u32x4*)rp; qr1[qt] = *(const u32x4*)(rp + 32); }
        __syncthreads();
        const int tidl = tid_opaque();
        float kwr[8];
#pragma unroll
        for (int j = 0; j < 8; ++j) kwr[j] = kw[(tidl & 7) * 8 + j];
#pragma unroll
        for (int i = 0; i < 4; ++i) {
            const int piece = tidl + 512 * i, key = piece >> 3, dseg = piece & 7; const bool valid = (qb > 0) || (key >= 128);
            u32x4 kr = (u32x4){0u, 0u, 0u, 0u}, vr = (u32x4){0u, 0u, 0u, 0u};
            if (valid) { const bf16_t* rp = proj + (size_t)(tok0 + key) * PROJW + kvh * 64 + dseg * 8; kr = *(const u32x4*)(rp + C_AK); vr = *(const u32x4*)(rp + C_AV); }
            float kf[8]; unpack8(kr, kf);
            float ss = 0.f;
#pragma unroll
            for (int j = 0; j < 8; ++j) ss += kf[j] * kf[j];
            ss += __shfl_xor(ss, 1); ss += __shfl_xor(ss, 2); ss += __shfl_xor(ss, 4);
            const float r = rsqrtf(ss * (1.0f / 64.0f) + 1e-6f);
            *(LAS bf16x8*)(lds + KS_OFF + key * KS_STRIDE + dseg * 16) = pack8(kf[0] * r * kwr[0], kf[1] * r * kwr[1], kf[2] * r * kwr[2], kf[3] * r * kwr[3], kf[4] * r * kwr[4], kf[5] * r * kwr[5], kf[6] * r * kwr[6], kf[7] * r * kwr[7]);
            const unsigned vw[4] = {vr.x, vr.y, vr.z, vr.w};
            const int ks = key ^ (dseg << 3);
#pragma unroll
            for (int j = 0; j < 8; ++j) *(LAS bf16_t*)(lds + VT_OFF + (dseg * 8 + j) * VT_STRIDE + ks * 2) = (bf16_t)((j & 1) ? (vw[j >> 1] >> 16) : (vw[j >> 1] & 0xffffu));
        }
        __syncthreads();
        bf16x8 Qf[4][2];
        {   float qw0[8], qw1[8];
#pragma unroll
            for (int j = 0; j < 8; ++j) { qw0[j] = qw[kq * 8 + j]; qw1[j] = qw[32 + kq * 8 + j]; }
#pragma unroll
            for (int qt = 0; qt < 4; ++qt) {
                float x0[8], x1[8]; unpack8(qr0[qt], x0); unpack8(qr1[qt], x1);
                float ss = 0.f;
#pragma unroll
                for (int j = 0; j < 8; ++j) ss += x0[j] * x0[j] + x1[j] * x1[j];
                ss += __shfl_xor(ss, 16); ss += __shfl_xor(ss, 32);
                const float r = rsqrtf(ss * (1.0f / 64.0f) + 1e-6f) * 0.125f * L2E;
                Qf[qt][0] = pack8(x0[0] * r * qw0[0], x0[1] * r * qw0[1], x0[2] * r * qw0[2], x0[3] * r * qw0[3], x0[4] * r * qw0[4], x0[5] * r * qw0[5], x0[6] * r * qw0[6], x0[7] * r * qw0[7]);
                Qf[qt][1] = pack8(x1[0] * r * qw1[0], x1[1] * r * qw1[1], x1[2] * r * qw1[2], x1[3] * r * qw1[3], x1[4] * r * qw1[4], x1[5] * r * qw1[5], x1[6] * r * qw1[6], x1[7] * r * qw1[7]);
            }
        }
        f32x4 O[4][4]; float lsum[4];
#pragma unroll
        for (int qt = 0; qt < 4; ++qt) { lsum[qt] = 0.f;
#pragma unroll
            for (int dt = 0; dt < 4; ++dt) O[qt][dt] = (f32x4){0.f, 0.f, 0.f, 0.f}; }
        const float sl2 = exp2f(-0.5f * (float)(h + 1)) * L2E;
        const int vsw = (qq >> 3) << 3;
#pragma unroll 1
        for (int kt3 = 0; kt3 < 3; ++kt3) {
            const int kt = qhalf + kt3;
#pragma unroll 1
            for (int sp = 0; sp < 2; ++sp) {
                bf16x8 Kf[2][2]; u32x2 Vr[4][2];
#pragma unroll
                for (int h2 = 0; h2 < 2; ++h2) { const int krow = kt * 64 + (2 * sp + h2) * 16 + qq;
                    Kf[h2][0] = *(const LAS bf16x8*)(lds + KS_OFF + krow * KS_STRIDE + kq * 16); Kf[h2][1] = *(const LAS bf16x8*)(lds + KS_OFF + krow * KS_STRIDE + 64 + kq * 16); }
#pragma unroll
                for (int dt = 0; dt < 4; ++dt) { const int off0 = ((kt * 64 + 32 * sp + 4 * kq) ^ ((dt << 4) | vsw)) * 2;
                    const LAS unsigned char* vp = lds + VT_OFF + (dt * 16 + qq) * VT_STRIDE;
                    Vr[dt][0] = *(const LAS u32x2*)(vp + off0); Vr[dt][1] = *(const LAS u32x2*)(vp + (off0 ^ 32)); }
                u32x2 Ph[4][2];
#pragma unroll
                for (int h2 = 0; h2 < 2; ++h2) {
#pragma unroll
                    for (int qt = 0; qt < 4; ++qt) {
                        f32x4 a = MFMA16(Kf[h2][0], Qf[qt][0], ((f32x4){0.f, 0.f, 0.f, 0.f})); a = MFMA16(Kf[h2][1], Qf[qt][1], a);
                        float p[4];
#pragma unroll
                        for (int r = 0; r < 4; ++r) {
                            const int ki = kt * 64 + (2 * sp + h2) * 16 + 4 * kq + r, qi = qhalf * 64 + qt * 16 + qq, dist = 128 + qi - ki;
                            const bool valid = ((unsigned)dist < 128u) && ((qb > 0) || (ki >= 128));
                            const float e = __builtin_amdgcn_exp2f(a[r] - sl2 * (float)dist - m02);
                            p[r] = valid ? e : 0.f; lsum[qt] += p[r];
                        }
                        Ph[qt][h2].x = pg8::cvt_pk_bf16(p[0], p[1]); Ph[qt][h2].y = pg8::cvt_pk_bf16(p[2], p[3]);
                    }
                }
#pragma unroll
                for (int dt = 0; dt < 4; ++dt) {
                    const bf16x8 Vf = __builtin_bit_cast(bf16x8, ((u32x4){Vr[dt][0].x, Vr[dt][0].y, Vr[dt][1].x, Vr[dt][1].y}));
#pragma unroll
                    for (int qt = 0; qt < 4; ++qt) O[qt][dt] = MFMA16(Vf, __builtin_bit_cast(bf16x8, ((u32x4){Ph[qt][0].x, Ph[qt][0].y, Ph[qt][1].x, Ph[qt][1].y})), O[qt][dt]);
                }
            }
        }
        const float es = __builtin_amdgcn_exp2f(sinks[h] * L2E - m02);
#pragma unroll
        for (int qt = 0; qt < 4; ++qt) {
            float l = lsum[qt]; l += __shfl_xor(l, 16); l += __shfl_xor(l, 32);
            const float inv = __builtin_amdgcn_rcpf(l + es);
            bf16_t* op = mixed + ((size_t)b * SEQ + qb * 128 + qhalf * 64 + qt * 16 + qq) * D + h * 64 + 4 * kq;
#pragma unroll
            for (int dt = 0; dt < 4; ++dt) { u32x2 w2; w2.x = pg8::cvt_pk_bf16(O[qt][dt][0] * inv, O[qt][dt][1] * inv); w2.y = pg8::cvt_pk_bf16(O[qt][dt][2] * inv, O[qt][dt][3] * inv); *(u32x2*)(op + dt * 16) = w2; }
        }
    }
}
}
namespace gdn {
constexpr int NITEMS = BATCH * 32 * 8;
constexpr int KS_OFF = 0, QS_OFF = KS_OFF + 64 * 272, KBT_OFF = QS_OFF + 64 * 272, VBT_OFF = KBT_OFF + 128 * 144, PB_OFF = VBT_OFF + 128 * 144;
constexpr int PBUF = 27648, KDT_OFF = PB_OFF + PBUF;
constexpr int GC_OFF = PB_OFF + 2 * PBUF, BT_OFF = GC_OFF + 256, CW_OFF = BT_OFF + 256, PREP_LDS = CW_OFF + 6144;
constexpr int SC_BUF = 57344, SC_OT_OFF = 2 * SC_BUF, SC_OT_STRIDE = 528, SC_NW_OFF = SC_OT_OFF + 64 * SC_OT_STRIDE, SCAN_LDS = SC_NW_OFF + 512;

__device__ __forceinline__ u32x2 pack4(float a, float b, float c, float d) { u32x2 r; r.x = pg8::cvt_pk_bf16(a, b); r.y = pg8::cvt_pk_bf16(c, d); return r; }

__device__ __forceinline__ void conv_load(const bf16_t* __restrict__ proj, size_t t0, int c, int n, int colbase, u32x4 (&r)[4][2]) {
#pragma unroll
    for (int tap = 0; tap < 4; ++tap) {
        const int tr = c - 3 + tap;
        r[tap][0] = (u32x4){0u, 0u, 0u, 0u}; r[tap][1] = r[tap][0];
        if (n > 0 || tr >= 0) { const bf16_t* rp = proj + (size_t)((long)t0 + tr) * PROJW + colbase; r[tap][0] = *(const u32x4*)rp; r[tap][1] = *(const u32x4*)(rp + 8); }
    }
}
__device__ __forceinline__ void conv16(const u32x4 (&r)[4][2], const LAS float* cwm, int seg, float (&out)[16]) {
#pragma unroll
    for (int j = 0; j < 16; ++j) out[j] = 0.f;
#pragma unroll
    for (int tap = 0; tap < 4; ++tap) {
        float x0[8], x1[8]; unpack8(r[tap][0], x0); unpack8(r[tap][1], x1);
        const LAS f32x4* wp = (const LAS f32x4*)(cwm + tap * 128 + seg * 16);
        const f32x4 w0 = wp[0], w1 = wp[1], w2 = wp[2], w3 = wp[3];
#pragma unroll
        for (int j = 0; j < 4; ++j) { out[j] += w0[j] * x0[j]; out[4 + j] += w1[j] * x0[4 + j]; out[8 + j] += w2[j] * x1[j]; out[12 + j] += w3[j] * x1[4 + j]; }
    }
#pragma unroll
    for (int j = 0; j < 16; ++j) out[j] = siluf_(out[j]);
}

__device__ __forceinline__ void prep_phase(LAS unsigned char* lds, const bf16_t* __restrict__ proj, const float* __restrict__ beta, const float* __restrict__ gdec, const float* __restrict__ conv_w,
                                           bf16_t* __restrict__ NEGW, bf16_t* __restrict__ QG, bf16_t* __restrict__ KDT, bf16_t* __restrict__ AM, bf16_t* __restrict__ UT, float* __restrict__ GLAST,
                                           int n0, int ns, int first, int stride) {
    const int tid = tid_opaque(), w = __builtin_amdgcn_readfirstlane(tid >> 6), lane = tid & 63, qq = lane & 15, kq = lane >> 4;
    const int c = tid >> 3, seg = tid & 7;
    LAS float* GC = (LAS float*)(lds + GC_OFF); LAS float* BT = (LAS float*)(lds + BT_OFF); LAS float* CW = (LAS float*)(lds + CW_OFF);
    int cur_hh = -1;
    const int nv = BATCH * 8 * ns;
#define PREP_ITEM(v_) ((((v_) / (8 * ns)) * 32 + n0 + (((v_) >> 3) % ns)) * 8 + ((v_) & 7))
    u32x4 rq[4][2], rk[4][2];
#define PREP_LOAD(item_) do { const int hh_ = (item_) & 7, n_ = ((item_) >> 3) & 31, b_ = (item_) >> 8; const size_t t0_ = (size_t)b_ * SEQ + n_ * 64; const int tl_ = tid_opaque(), c_ = tl_ >> 3, sg_ = tl_ & 7; \
        conv_load(proj, t0_, c_, n_, C_DQ + hh_ * 128 + sg_ * 16, rq); conv_load(proj, t0_, c_, n_, C_DK + hh_ * 128 + sg_ * 16, rk); } while (0)
    if (first < nv) { const int it0 = PREP_ITEM(first); PREP_LOAD(it0); }
    for (int vi = first; vi < nv; vi += stride) {
        const int item = PREP_ITEM(vi);
        const int hh = item & 7, n = (item >> 3) & 31, b = item >> 8;
        const size_t t0 = (size_t)b * SEQ + n * 64;
        u32x4 rv[4][2]; { const int tl_ = tid_opaque(); conv_load(proj, t0, tl_ >> 3, n, C_DV + hh * 128 + (tl_ & 7) * 16, rv); }
        __syncthreads();
        if (hh != cur_hh) { for (int i = tid; i < 1536; i += 512) { const int mtx = i >> 9, rem = i & 511, tap = rem >> 7, ch = rem & 127; CW[i] = conv_w[tap * 3072 + mtx * 1024 + hh * 128 + ch]; } cur_hh = hh; }
        float gv = gdec[(t0 + lane) * 8 + hh];
#pragma unroll
        for (int o = 1; o < 64; o <<= 1) { const float t = __shfl_up(gv, o); if (lane >= o) gv += t; }
        const float glast = __shfl(gv, 63);
        const float gcc = __shfl(gv, (w * 8 + (lane >> 3)) & 63);
        const float bc = beta[(t0 + c) * 8 + hh];
        if (w == 0) { GC[lane] = gv; BT[lane] = beta[(t0 + lane) * 8 + hh]; }
        if (tid == 0) GLAST[item] = __expf(glast);
        __syncthreads();
        const float egc = __expf(gcc), edk = __expf(glast - gcc);
        const int cs = c ^ (seg << 3);
        {
            float qv[16]; conv16(rq, CW, seg, qv);
            float ss = 0.f;
#pragma unroll
            for (int j = 0; j < 16; ++j) ss += qv[j] * qv[j];
            ss += __shfl_xor(ss, 1); ss += __shfl_xor(ss, 2); ss += __shfl_xor(ss, 4);
            const float rq = rsqrtf(ss + 1e-6f) * 0.08838834764831845f;
#pragma unroll
            for (int j = 0; j < 16; ++j) qv[j] *= rq;
            LAS unsigned char* qp = lds + QS_OFF + c * 272 + seg * 32;
            *(LAS bf16x8*)qp = pack8(qv[0], qv[1], qv[2], qv[3], qv[4], qv[5], qv[6], qv[7]); *(LAS bf16x8*)(qp + 16) = pack8(qv[8], qv[9], qv[10], qv[11], qv[12], qv[13], qv[14], qv[15]);
            bf16_t* qg = QG + (size_t)item * 8192;
#pragma unroll
            for (int q4 = 0; q4 < 4; ++q4)
                *(u32x2*)(qg + ((((c >> 4) * 4 + (seg >> 1)) * 64 + q4 * 16 + (c & 15)) * 8 + (seg & 1) * 4)) = pack4(qv[4 * q4] * egc, qv[4 * q4 + 1] * egc, qv[4 * q4 + 2] * egc, qv[4 * q4 + 3] * egc);
        }
        {
            float kv[16]; conv16(rk, CW + 512, seg, kv);
            float ss = 0.f;
#pragma unroll
            for (int j = 0; j < 16; ++j) ss += kv[j] * kv[j];
            ss += __shfl_xor(ss, 1); ss += __shfl_xor(ss, 2); ss += __shfl_xor(ss, 4);
            const float rk = rsqrtf(ss + 1e-6f);
#pragma unroll
            for (int j = 0; j < 16; ++j) kv[j] *= rk;
            LAS unsigned char* kp = lds + KS_OFF + c * 272 + seg * 32;
            *(LAS bf16x8*)kp = pack8(kv[0], kv[1], kv[2], kv[3], kv[4], kv[5], kv[6], kv[7]); *(LAS bf16x8*)(kp + 16) = pack8(kv[8], kv[9], kv[10], kv[11], kv[12], kv[13], kv[14], kv[15]);
            const float sb = bc * egc;
#pragma unroll
            for (int j = 0; j < 16; ++j) { *(LAS bf16_t*)(lds + KBT_OFF + (seg * 16 + j) * 144 + cs * 2) = f2bf(kv[j] * sb); *(LAS bf16_t*)(lds + KDT_OFF + (seg * 16 + j) * 144 + cs * 2) = f2bf(kv[j] * edk); }
        }
        {
            float vv[16]; conv16(rv, CW + 1024, seg, vv);
#pragma unroll
            for (int j = 0; j < 16; ++j) *(LAS bf16_t*)(lds + VBT_OFF + (seg * 16 + j) * 144 + cs * 2) = f2bf(vv[j] * bc);
        }
        __syncthreads();
        {   bf16_t* kd = KDT + (size_t)item * 8192;
#pragma unroll
            for (int i = 0; i < 4; ++i) { const int piece = tid + 512 * i, dk = piece >> 4, pp = piece & 15;
                const u32x2 v = *(const LAS u32x2*)(lds + KDT_OFF + dk * 144 + (((pp >> 1) ^ (dk >> 4)) * 16) + (pp & 1) * 8);
                *(u32x2*)(kd + ((((dk >> 4) * 2 + (pp >> 3)) * 64 + (pp & 3) * 16 + (dk & 15)) * 8 + ((pp >> 2) & 1) * 4)) = v; }
        }
#pragma unroll
        for (int tsel = 0; tsel < 2; ++tsel) {
            const int ti = 2 * w + tsel, ta = ti >> 2, tb = ti & 3;
            f32x4 akk = (f32x4){0.f, 0.f, 0.f, 0.f}, aqk = akk;
#pragma unroll
            for (int s4 = 0; s4 < 4; ++s4) {
                const bf16x8 A = *(const LAS bf16x8*)(lds + KS_OFF + (16 * ta + qq) * 272 + s4 * 64 + kq * 16);
                const bf16x8 Bk = *(const LAS bf16x8*)(lds + KS_OFF + (16 * tb + qq) * 272 + s4 * 64 + kq * 16);
                const bf16x8 Bq = *(const LAS bf16x8*)(lds + QS_OFF + (16 * tb + qq) * 272 + s4 * 64 + kq * 16);
                akk = MFMA16(A, Bk, akk); aqk = MFMA16(A, Bq, aqk);
            }
            const int y = 16 * tb + qq, x0 = 16 * ta + 4 * kq;
            const float gcy = GC[y], by = BT[y];
            float v1[4], v2[4], xv[4], av[4];
#pragma unroll
            for (int r = 0; r < 4; ++r) { const int x = x0 + r; const float gcx = GC[x], bx = BT[x];
                const float e_yx = (y >= x) ? __expf(gcy - gcx) : 0.f;
                const float e_xy = (x > y) ? __expf(gcx - gcy) : 0.f;
                v1[r] = (y > x) ? by * akk[r] * e_yx : 0.f;
                v2[r] = bx * akk[r] * e_xy;
                xv[r] = ((y == x) ? 1.f : 0.f) - v1[r];
                av[r] = aqk[r] * e_yx; }
            *(LAS u32x2*)(lds + PB_OFF + y * 144 + x0 * 2) = pack4(v1[0], v1[1], v1[2], v1[3]);
            *(LAS u32x2*)(lds + PB_OFF + 9216 + y * 144 + x0 * 2) = pack4(v2[0], v2[1], v2[2], v2[3]);
            *(LAS u32x2*)(lds + PB_OFF + 18432 + y * 144 + x0 * 2) = pack4(xv[0], xv[1], xv[2], xv[3]);
            *(u32x2*)(AM + (size_t)item * 4096 + (((tb * 2 + (ta >> 1)) * 64 + lane) * 8 + (ta & 1) * 4)) = pack4(av[0], av[1], av[2], av[3]);
        }
        __syncthreads();
        if (vi + stride < nv) { const int itn = PREP_ITEM(vi + stride); PREP_LOAD(itn); }
#pragma unroll 1
        for (int ph = 0; ph <= 5; ++ph) {
            const int bc_ = PB_OFF + (ph & 1) * PBUF, bn_ = PB_OFF + ((ph + 1) & 1) * PBUF;
            const int pa_cur = bc_, pt_cur = bc_ + 9216, x_new = bc_ + 18432, pa_new = bn_, pt_new = bn_ + 9216, x_prev = bn_ + 18432;
#pragma unroll
            for (int tsel = 0; tsel < 2; ++tsel) {
                const int ti = 2 * w + tsel, ta = ti >> 2, tb = ti & 3;
                const int ra = (16 * ta + qq) * 144 + kq * 16, rb = (16 * tb + qq) * 144 + kq * 16, wo = (16 * tb + qq) * 144 + (16 * ta + 4 * kq) * 2;
                const bf16x8 PAa0 = *(const LAS bf16x8*)(lds + pa_cur + ra), PAa1 = *(const LAS bf16x8*)(lds + pa_cur + ra + 64);
                const bf16x8 PTa0 = *(const LAS bf16x8*)(lds + pt_cur + ra), PTa1 = *(const LAS bf16x8*)(lds + pt_cur + ra + 64);
                if (ph < 5) {
                    const bf16x8 PAb0 = *(const LAS bf16x8*)(lds + pa_cur + rb), PAb1 = *(const LAS bf16x8*)(lds + pa_cur + rb + 64);
                    const bf16x8 PTb0 = *(const LAS bf16x8*)(lds + pt_cur + rb), PTb1 = *(const LAS bf16x8*)(lds + pt_cur + rb + 64);
                    f32x4 d1 = MFMA16(PAa0, PTb0, ((f32x4){0.f, 0.f, 0.f, 0.f})); d1 = MFMA16(PAa1, PTb1, d1);
                    f32x4 d2 = MFMA16(PTa0, PAb0, ((f32x4){0.f, 0.f, 0.f, 0.f})); d2 = MFMA16(PTa1, PAb1, d2);
                    *(LAS u32x2*)(lds + pt_new + wo) = pack4(d1[0], d1[1], d1[2], d1[3]);
                    *(LAS u32x2*)(lds + pa_new + wo) = pack4(d2[0], d2[1], d2[2], d2[3]);
                }
                if (ph >= 1) {
                    const bf16x8 Xb0 = *(const LAS bf16x8*)(lds + x_prev + rb), Xb1 = *(const LAS bf16x8*)(lds + x_prev + rb + 64);
                    const u32x2 xc = *(const LAS u32x2*)(lds + x_prev + wo);
                    f32x4 d3 = (f32x4){__uint_as_float(xc.x << 16), __uint_as_float(xc.x & 0xffff0000u), __uint_as_float(xc.y << 16), __uint_as_float(xc.y & 0xffff0000u)};
                    d3 = MFMA16(PTa0, Xb0, d3); d3 = MFMA16(PTa1, Xb1, d3);
                    *(LAS u32x2*)(lds + x_new + wo) = pack4(d3[0], d3[1], d3[2], d3[3]);
                }
            }
            __syncthreads();
        }
        {   const int x5 = PB_OFF + PBUF + 18432;
#pragma unroll
            for (int tt = 0; tt < 4; ++tt) {
                const int tu = 4 * w + tt;
                {   const int ta = tu & 3, tb = tu >> 2;
                    f32x4 d = (f32x4){0.f, 0.f, 0.f, 0.f};
#pragma unroll
                    for (int s2 = 0; s2 < 2; ++s2) d = MFMA16(*(const LAS bf16x8*)(lds + x5 + (16 * ta + qq) * 144 + s2 * 64 + kq * 16), *(const LAS bf16x8*)(lds + VBT_OFF + (16 * tb + qq) * 144 + (((4 * s2 + kq) ^ tb) * 16)), d);
                    *(u32x2*)(UT + (size_t)item * 8192 + ((tb * 4 + ta) * 64 + lane) * 4) = pack4(d[0], d[1], d[2], d[3]); }
                {   const int ta = tu >> 2, tb = tu & 3;
                    f32x4 d = (f32x4){0.f, 0.f, 0.f, 0.f};
#pragma unroll
                    for (int s2 = 0; s2 < 2; ++s2) d = MFMA16(*(const LAS bf16x8*)(lds + KBT_OFF + (16 * ta + qq) * 144 + (((4 * s2 + kq) ^ ta) * 16)), *(const LAS bf16x8*)(lds + x5 + (16 * tb + qq) * 144 + s2 * 64 + kq * 16), d);
                    *(u32x2*)(NEGW + (size_t)item * 8192 + (((tb * 4 + (ta >> 1)) * 64 + lane) * 8 + (ta & 1) * 4)) = pack4(-d[0], -d[1], -d[2], -d[3]); }
            }
        }
    }
#undef PREP_LOAD
#undef PREP_ITEM
}

template <class GridBar>
__device__ __forceinline__ void scan_phase(LAS unsigned char* lds, const bf16_t* __restrict__ NEGW, const bf16_t* __restrict__ QG, const bf16_t* __restrict__ KDT, const bf16_t* __restrict__ AM,
                                           const bf16_t* __restrict__ UT, const float* __restrict__ GLAST, const bf16_t* __restrict__ proj, const float* __restrict__ dn_norm_w, bf16_t* __restrict__ mixed, int bh,
                                           int nsplit, const GridBar& gridbar) {
    const int tid = tid_opaque(), w = __builtin_amdgcn_readfirstlane(tid >> 6), lane = tid & 63, qq = lane & 15, kq = lane >> 4;
    const int b = bh >> 3, hh = bh & 7, c = tid >> 3, seg = tid & 7;
    f32x4 S[8];
#pragma unroll
    for (int i = 0; i < 8; ++i) S[i] = (f32x4){0.f, 0.f, 0.f, 0.f};
#define GDN_STAGE(nn, bufoff) do { const size_t it_ = (size_t)((b * 32 + (nn)) * 8 + hh); \
        _Pragma("unroll") for (int i_ = 0; i_ < 7; ++i_) { const bf16_t* src_ = (i_ < 2) ? NEGW + it_ * 8192 + (i_ * 512 + tid) * 8 : (i_ < 4) ? QG + it_ * 8192 + ((i_ - 2) * 512 + tid) * 8 \
            : (i_ < 6) ? KDT + it_ * 8192 + ((i_ - 4) * 512 + tid) * 8 : AM + it_ * 4096 + tid * 8; \
            __builtin_amdgcn_global_load_lds((const unsigned*)src_, (LAS unsigned*)(lds + (bufoff) + i_ * 8192 + w * 1024), 16, 0, 0); } } while (0)
    if (tid < 128) *(LAS float*)(lds + SC_NW_OFF + tid * 4) = dn_norm_w[tid];
    GDN_STAGE(0, 0);
    u32x2 uu_n[4]; float gl_n; u32x4 z0_n, z1_n;
#define GDN_LOADS(nn) do { const size_t it_ = (size_t)((b * 32 + (nn)) * 8 + hh), t0_ = (size_t)b * SEQ + (nn) * 64; \
        const bf16_t* up_ = UT + it_ * 8192 + (w * 4 * 64 + lane) * 4; const float* gp_ = GLAST + it_; const bf16_t* zp_ = proj + (t0_ + c) * PROJW + C_DZ + hh * 128 + seg * 16; \
        asm volatile("global_load_dwordx2 %0, %7, off\n\tglobal_load_dwordx2 %1, %7, off offset:512\n\tglobal_load_dwordx2 %2, %7, off offset:1024\n\tglobal_load_dwordx2 %3, %7, off offset:1536\n\t" \
                     "global_load_dword %4, %8, off\n\tglobal_load_dwordx4 %5, %9, off\n\tglobal_load_dwordx4 %6, %9, off offset:16" \
                     : "=&v"(uu_n[0]), "=&v"(uu_n[1]), "=&v"(uu_n[2]), "=&v"(uu_n[3]), "=&v"(gl_n), "=&v"(z0_n), "=&v"(z1_n) : "v"(up_), "v"(gp_), "v"(zp_) : "memory"); } while (0)
#define GDN_LOADS_WAIT() asm volatile("s_waitcnt vmcnt(0)" : "+v"(uu_n[0]), "+v"(uu_n[1]), "+v"(uu_n[2]), "+v"(uu_n[3]), "+v"(gl_n), "+v"(z0_n), "+v"(z1_n) :: "memory")
    GDN_LOADS(0);
    GDN_LOADS_WAIT();
    __syncthreads();
#pragma unroll 1
    for (int n = 0; n < 32; ++n) {
        const int buf = (n & 1) * SC_BUF;
        const size_t t0 = (size_t)b * SEQ + n * 64;
        f32x4 vn[4];
#pragma unroll
        for (int mt = 0; mt < 4; ++mt) vn[mt] = (f32x4){__uint_as_float(uu_n[mt].x << 16), __uint_as_float(uu_n[mt].x & 0xffff0000u), __uint_as_float(uu_n[mt].y << 16), __uint_as_float(uu_n[mt].y & 0xffff0000u)};
        const float gl = gl_n; const u32x4 z0 = z0_n, z1 = z1_n;
        if (n + 1 == nsplit) gridbar();
        if (n + 1 < 32) { GDN_STAGE(n + 1, SC_BUF - buf); GDN_LOADS(n + 1); }
        bf16x8 Sb[4];
#pragma unroll
        for (int s4 = 0; s4 < 4; ++s4) Sb[s4] = pack8(S[2 * s4][0], S[2 * s4][1], S[2 * s4][2], S[2 * s4][3], S[2 * s4 + 1][0], S[2 * s4 + 1][1], S[2 * s4 + 1][2], S[2 * s4 + 1][3]);
        f32x4 o[4];
        bf16x8 F1[16], F2[16];
#pragma unroll
        for (int i = 0; i < 16; ++i) F1[i] = *(const LAS bf16x8*)(lds + buf + (i * 64 + lane) * 16);
#pragma unroll
        for (int i = 0; i < 16; ++i) F2[i] = *(const LAS bf16x8*)(lds + buf + 16384 + (i * 64 + lane) * 16);
        __builtin_amdgcn_sched_barrier(0);
#pragma unroll
        for (int s4 = 0; s4 < 4; ++s4)
#pragma unroll
            for (int mt = 0; mt < 4; ++mt) vn[mt] = MFMA16(F1[mt * 4 + s4], Sb[s4], vn[mt]);
#pragma unroll
        for (int mt = 0; mt < 4; ++mt) o[mt] = (f32x4){0.f, 0.f, 0.f, 0.f};
#pragma unroll
        for (int s4 = 0; s4 < 4; ++s4)
#pragma unroll
            for (int mt = 0; mt < 4; ++mt) o[mt] = MFMA16(F2[mt * 4 + s4], Sb[s4], o[mt]);
        __builtin_amdgcn_sched_barrier(0);
        bf16x8 F3[8];
#pragma unroll
        for (int i = 0; i < 8; ++i) F3[i] = *(const LAS bf16x8*)(lds + buf + 49152 + (i * 64 + lane) * 16);
#pragma unroll
        for (int i = 0; i < 16; ++i) F1[i] = *(const LAS bf16x8*)(lds + buf + 32768 + (i * 64 + lane) * 16);
        bf16x8 Vb[2];
#pragma unroll
        for (int s2 = 0; s2 < 2; ++s2) Vb[s2] = pack8(vn[2 * s2][0], vn[2 * s2][1], vn[2 * s2][2], vn[2 * s2][3], vn[2 * s2 + 1][0], vn[2 * s2 + 1][1], vn[2 * s2 + 1][2], vn[2 * s2 + 1][3]);
#pragma unroll
        for (int s2 = 0; s2 < 2; ++s2)
#pragma unroll
            for (int mt = 0; mt < 4; ++mt) o[mt] = MFMA16(F3[mt * 2 + s2], Vb[s2], o[mt]);
        __builtin_amdgcn_sched_barrier(0);
#pragma unroll
        for (int mt = 0; mt < 8; ++mt) S[mt] = S[mt] * gl;
#pragma unroll
        for (int s2 = 0; s2 < 2; ++s2)
#pragma unroll
            for (int mt = 0; mt < 8; ++mt) S[mt] = MFMA16(F1[mt * 2 + s2], Vb[s2], S[mt]);
#pragma unroll
        for (int mt = 0; mt < 4; ++mt)
#pragma unroll
            for (int r = 0; r < 4; ++r) *(LAS float*)(lds + SC_OT_OFF + (16 * mt + 4 * kq + r) * SC_OT_STRIDE + (16 * w + qq) * 4) = o[mt][r];
        asm volatile("s_waitcnt lgkmcnt(0)" ::: "memory"); __builtin_amdgcn_s_barrier(); asm volatile("" ::: "memory");
        {   const LAS f32x4* op = (const LAS f32x4*)(lds + SC_OT_OFF + c * SC_OT_STRIDE + seg * 64);
            const f32x4 o0 = op[0], o1 = op[1], o2 = op[2], o3 = op[3];
            float ov[16] = {o0[0], o0[1], o0[2], o0[3], o1[0], o1[1], o1[2], o1[3], o2[0], o2[1], o2[2], o2[3], o3[0], o3[1], o3[2], o3[3]};
            float ss = 0.f;
#pragma unroll
            for (int j = 0; j < 16; ++j) ss += ov[j] * ov[j];
            ss += __shfl_xor(ss, 1); ss += __shfl_xor(ss, 2); ss += __shfl_xor(ss, 4);
            const float r = rsqrtf(ss * (1.0f / 128.0f) + 1e-6f);
            float zf0[8], zf1[8]; unpack8(z0, zf0); unpack8(z1, zf1);
            float nw[16];
#pragma unroll
            for (int j = 0; j < 4; ++j) { const f32x4 t4 = *(const LAS f32x4*)(lds + SC_NW_OFF + (seg * 16 + 4 * j) * 4); nw[4 * j] = t4[0]; nw[4 * j + 1] = t4[1]; nw[4 * j + 2] = t4[2]; nw[4 * j + 3] = t4[3]; }
#pragma unroll
            for (int j = 0; j < 8; ++j) { ov[j] = ov[j] * r * nw[j] * siluf_(zf0[j]); ov[8 + j] = ov[8 + j] * r * nw[8 + j] * siluf_(zf1[j]); }
            bf16_t* mp = mixed + (t0 + c) * D + 1024 + hh * 128 + seg * 16;
            *(bf16x8*)mp = pack8(ov[0], ov[1], ov[2], ov[3], ov[4], ov[5], ov[6], ov[7]); *(bf16x8*)(mp + 8) = pack8(ov[8], ov[9], ov[10], ov[11], ov[12], ov[13], ov[14], ov[15]);
        }
        GDN_LOADS_WAIT();
        __syncthreads();
    }
#undef GDN_LOADS_WAIT
#undef GDN_STAGE
#undef GDN_LOADS
}
}

#define XB_TMO      128
#define XB_XCNT(j)  (256  + 64 * (j))
#define XB_XSUB(j)  (1280 + 64 * (j))
#define XB_XGEN(j)  (2304 + 64 * (j))
#define XB_TOP      3328
#define XB_TOPGEN   3392
#define XCD_BAR_WORDS 3456
#define XB_SPIN_CAP (1u << 18)
__device__ __forceinline__ unsigned xb_ld(unsigned* p)              { return __hip_atomic_load(p, __ATOMIC_RELAXED, __HIP_MEMORY_SCOPE_AGENT); }
__device__ __forceinline__ unsigned xb_add(unsigned* p, unsigned v) { return __hip_atomic_fetch_add(p, v, __ATOMIC_RELAXED, __HIP_MEMORY_SCOPE_AGENT); }
__device__ __forceinline__ unsigned xb_xcc_id() { return (unsigned)__builtin_amdgcn_s_getreg((3 << 11) | 20) & 0xFu; }
#define XB_SPIN(cond, bar) do { unsigned _sp = 0; while (cond) { __builtin_amdgcn_s_sleep(1); \
    if ((++_sp & 255u) == 0u) { if (xb_ld(&(bar)[XB_TMO])) break; if (_sp > XB_SPIN_CAP) { atomicAdd(&(bar)[XB_TMO], 1u); break; } } } } while (0)
struct XcdBarrier { unsigned* bar; unsigned x; volatile LAS unsigned* st; };
__device__ __forceinline__ XcdBarrier xcd_barrier_post(unsigned* bar, volatile LAS unsigned* st) {
    XcdBarrier b; b.bar = bar; b.x = xb_xcc_id(); b.st = st;
    if (threadIdx.x == 0) (void)xb_add(&bar[XB_XCNT(b.x)], 1u);
    return b;
}
__device__ __forceinline__ void xcd_barrier_complete(unsigned* bar, unsigned x, unsigned& nloc, unsigned& nx) {
    const unsigned G = gridDim.x * gridDim.y * gridDim.z;
    unsigned sum, cnt, mine, sp = 0u;
    for (;;) {
        sum = 0u; cnt = 0u; mine = 0u;
#pragma unroll
        for (unsigned j = 0; j < 16; ++j) { const unsigned c = xb_ld(&bar[XB_XCNT(j)]); sum += c; cnt += (c > 0u) ? 1u : 0u; mine = (j == x) ? c : mine; }
        if (sum == G) break;
        __builtin_amdgcn_s_sleep(1);
        if ((++sp & 255u) == 0u) { if (xb_ld(&bar[XB_TMO])) break; if (sp > XB_SPIN_CAP) { atomicAdd(&bar[XB_TMO], 1u); break; } }
    }
    nloc = mine > 0u ? mine : 1u; nx = cnt > 0u ? cnt : 1u;
}
__device__ __forceinline__ void xcd_barrier(const XcdBarrier& b) {
    asm volatile("s_waitcnt vmcnt(0)" ::: "memory");
    __syncthreads();
    if (threadIdx.x == 0) {
        unsigned* bar = b.bar;
        unsigned bx = b.x; asm volatile("" : "+s"(bx));
        __builtin_amdgcn_s_waitcnt(0);
        unsigned nloc = b.st[0], nx = b.st[1];
        if (nloc == 0u) { xcd_barrier_complete(bar, bx, nloc, nx); b.st[0] = nloc; b.st[1] = nx; }
        const unsigned old = xb_add(&bar[XB_XSUB(bx)], 1u);
        const unsigned gen = old / nloc;
        if (old + 1u == (gen + 1u) * nloc) {
            __builtin_amdgcn_fence(__ATOMIC_RELEASE, "agent");
            asm volatile("s_waitcnt vmcnt(0)" ::: "memory");
            const unsigned og = xb_add(&bar[XB_TOP], 1u);
            const unsigned tg = og / nx;
            if (og + 1u == (tg + 1u) * nx) xb_add(&bar[XB_TOPGEN], 1u);
            else XB_SPIN(xb_ld(&bar[XB_TOPGEN]) == tg, bar);
            __builtin_amdgcn_fence(__ATOMIC_ACQUIRE, "agent");
            xb_add(&bar[XB_XGEN(bx)], 1u);
            asm volatile("s_waitcnt vmcnt(0)" ::: "memory");
        } else {
            XB_SPIN(xb_ld(&bar[XB_XGEN(bx)]) == gen, bar);
            __builtin_amdgcn_fence(__ATOMIC_ACQUIRE, "agent");
            asm volatile("s_waitcnt vmcnt(0)" ::: "memory");
        }
    }
    __syncthreads();
}

constexpr int NWAVES = 8;
constexpr int PHASE_LDS = gdn::SCAN_LDS;
constexpr int XB_OFF = PHASE_LDS, LDS_BYTES = PHASE_LDS + 256;
static_assert(gdn::PREP_LDS <= PHASE_LDS && pg8::STAGE_BYTES <= PHASE_LDS && att::LDS_BYTES <= PHASE_LDS && LDS_BYTES <= 163840, "LDS map");

template <int MODE>
__device__ __forceinline__ void wT_tile(LAS float* t, const float* __restrict__ W, bf16_t* __restrict__ WT, int K, int N, int Npad, int tile, int ht, bool active) {
    const int ntn = Npad / 64, ntk = K / 64, per = ntn * ntk;
    const int bz = tile / per, rem = tile % per, n0 = (rem % ntn) * 64, k0 = (rem / ntn) * 64;
    const float* src = W + (size_t)bz * K * N; bf16_t* dst = WT + (size_t)bz * Npad * K;
    if (active) {
#pragma unroll
        for (int p = 0; p < 4; ++p) { const int kk = p * 16 + (ht >> 4), nn = (ht & 15) * 4;
            f32x4 v = (f32x4){0.f, 0.f, 0.f, 0.f};
            if (n0 + nn + 3 < N) v = *(const f32x4*)(src + (size_t)(k0 + kk) * N + n0 + nn);
            t[kk * 65 + nn] = v[0]; t[kk * 65 + nn + 1] = v[1]; t[kk * 65 + nn + 2] = v[2]; t[kk * 65 + nn + 3] = v[3]; }
    }
    __syncthreads();
    if (active) {
        const int n = ht >> 2, ks = (ht & 3) * 16; const int c = n0 + n;
        int drow = c;
        if (MODE == 1) drow = ((c % 2048) / 128) * 256 + (c / 2048) * 128 + (c % 128);
        u32x4 w0, w1;
#define TT(i) t[(ks + (i)) * 65 + n]
        w0.x = pk2(TT(0), TT(1)); w0.y = pk2(TT(2), TT(3)); w0.z = pk2(TT(4), TT(5)); w0.w = pk2(TT(6), TT(7));
        w1.x = pk2(TT(8), TT(9)); w1.y = pk2(TT(10), TT(11)); w1.z = pk2(TT(12), TT(13)); w1.w = pk2(TT(14), TT(15));
#undef TT
        bf16_t* o = dst + (size_t)drow * K + k0 + ks;
        *(u32x4*)o = w0; *(u32x4*)(o + 8) = w1;
    }
    __syncthreads();
}
template <int MODE>
__device__ __forceinline__ void wT_phase(LAS unsigned char* lds, const float* W, bf16_t* WT, int K, int N, int Npad, int batch, int wg, int G) {
    const int tid = tid_opaque(), half = tid >> 8, ht = tid & 255;
    LAS float* t = (LAS float*)(lds + half * 16640);
    const int ntiles = batch * (Npad / 64) * (K / 64);
    for (int base = wg * 2; base < ntiles; base += G * 2) { const int tile = base + half; wT_tile<MODE>(t, W, WT, K, N, Npad, tile < ntiles ? tile : 0, ht, tile < ntiles); }
}
template <int MODE>
__device__ __forceinline__ void wT8_phase(LAS unsigned char* lds, const float* __restrict__ W, unsigned char* __restrict__ WT, int K, int N, int batch, unsigned* ctr) {
    const int tid = tid_opaque(), nn4 = tid & 15, kq = tid >> 4;
    const int ntn = N / 64, ntk = K / 256, per = ntn * ntk, ntiles = batch * per;
    LAS int* q = (LAS int*)(lds + 32768);
    f32x4 v[8], vn[8];
#define WT8_LOAD(dst, tile_) do { const int bz_ = (tile_) / per, rem_ = (tile_) % per, n0_ = (rem_ % ntn) * 64, k0_ = (rem_ / ntn) * 256; \
        const float* src_ = W + (size_t)bz_ * K * N + (size_t)(k0_ + kq * 8) * N + n0_ + nn4 * 4; \
        _Pragma("unroll") for (int r = 0; r < 8; ++r) dst[r] = __builtin_nontemporal_load((const f32x4*)(src_ + (size_t)r * N)); } while (0)
    __syncthreads();
    if (tid == 0) { const int r0 = (int)atomicAdd(ctr, 2u); q[0] = r0; q[1] = r0 + 1; }
    __syncthreads();
    int sup = q[0], supn = q[1], sub = 0;
    __syncthreads();
    int tile = 2 * sup;
    if (tile < ntiles) WT8_LOAD(vn, tile);
    while (tile < ntiles) {
        const int bz = tile / per, rem = tile % per, n0 = (rem % ntn) * 64, k0 = (rem / ntn) * 256;
        const int nxt = sub ? ((supn < 0x3fffffff) ? 2 * supn : 0x7fffffff) : tile + 1;
        int fut = 0x7fffffff;
        if (sub) { if (tid == 0 && nxt < ntiles) fut = (int)atomicAdd(ctr, 1u); }
#pragma unroll
        for (int r = 0; r < 8; ++r) v[r] = vn[r];
        if (nxt < ntiles) WT8_LOAD(vn, nxt);
        __syncthreads();
#pragma unroll
        for (int g = 0; g < 2; ++g)
#pragma unroll
            for (int j = 0; j < 4; ++j)
                *(LAS unsigned*)(lds + (nn4 * 4 + j) * 272 + kq * 8 + g * 4) = pk4_fp8(v[4 * g][j] * W_SCALE, v[4 * g + 1][j] * W_SCALE, v[4 * g + 2][j] * W_SCALE, v[4 * g + 3][j] * W_SCALE);
        if (sub && tid == 0) q[0] = fut;
        __syncthreads();
        unsigned char* dst = WT + (size_t)bz * N * K;
#pragma unroll
        for (int i = 0; i < 2; ++i) { const int pc = tid + 512 * i, row = pc >> 4, sg = pc & 15; const int c = n0 + row;
            int drow = c;
            if (MODE == 1) drow = ((c % 2048) / 128) * 256 + (c / 2048) * 128 + (c % 128);
            __builtin_nontemporal_store(*(const LAS u32x4*)(lds + row * 272 + sg * 16), (u32x4*)(dst + (size_t)drow * K + k0 + sg * 16)); }
        if (sub) { sup = supn; supn = q[0]; }
        sub ^= 1; tile = nxt;
    }
#undef WT8_LOAD
    __syncthreads();
}
__device__ __forceinline__ void rms_phase(const float* x, const float* w, bf16_t* o, float eps, int wg, int G) {
    const int tid = tid_opaque(), wave = tid >> 6, lane = tid & 63;
    for (int row = wg * NWAVES + wave; row < T; row += G * NWAVES) {
        const f32x4* xr = (const f32x4*)(x + (size_t)row * D) + lane; const f32x4* wr = (const f32x4*)w + lane;
        f32x4 v[8]; float s = 0.f;
#pragma unroll
        for (int j = 0; j < 8; ++j) { v[j] = xr[64 * j]; s += (v[j][0] * v[j][0] + v[j][1] * v[j][1]) + (v[j][2] * v[j][2] + v[j][3] * v[j][3]); }
        const float r = rsqrtf(wave_sum(s) * (1.0f / D) + eps);
        u32x2* o8 = (u32x2*)(o + (size_t)row * D) + lane;
#pragma unroll
        for (int j = 0; j < 8; ++j) { const f32x4 g = wr[64 * j]; u32x2 q; q.x = pk2(v[j][0] * r * g[0], v[j][1] * r * g[1]); q.y = pk2(v[j][2] * r * g[2], v[j][3] * r * g[3]); o8[64 * j] = q; }
    }
}
__device__ __forceinline__ unsigned pk4_i8(float a, float b, float c, float d) {
    const int ia = (int)rintf(a), ib = (int)rintf(b), ic = (int)rintf(c), id = (int)rintf(d);
    return ((unsigned)ia & 255u) | (((unsigned)ib & 255u) << 8) | (((unsigned)ic & 255u) << 16) | ((unsigned)id << 24); }
__device__ __forceinline__ void rms8_phase(const float* x, const float* w, unsigned char* o, float* xs, float eps, int wg, int G) {
    const int tid = tid_opaque(), wave = tid >> 6, lane = tid & 63;
    for (int row = wg * NWAVES + wave; row < T; row += G * NWAVES) {
        const f32x4* xr = (const f32x4*)(x + (size_t)row * D) + lane; const f32x4* wr = (const f32x4*)w + lane;
        f32x4 v[8]; float s = 0.f;
#pragma unroll
        for (int j = 0; j < 8; ++j) { v[j] = xr[64 * j]; s += (v[j][0] * v[j][0] + v[j][1] * v[j][1]) + (v[j][2] * v[j][2] + v[j][3] * v[j][3]); }
        const float r = rsqrtf(wave_sum(s) * (1.0f / D) + eps);
        float am = 0.f;
#pragma unroll
        for (int j = 0; j < 8; ++j) { const f32x4 g = wr[64 * j]; v[j][0] *= r * g[0]; v[j][1] *= r * g[1]; v[j][2] *= r * g[2]; v[j][3] *= r * g[3];
            am = fmaxf(am, fmaxf(fmaxf(fabsf(v[j][0]), fabsf(v[j][1])), fmaxf(fabsf(v[j][2]), fabsf(v[j][3])))); }
#pragma unroll
        for (int o2 = 1; o2 < 64; o2 <<= 1) am = fmaxf(am, __shfl_xor(am, o2));
        am = fmaxf(am, 1e-20f);
        const float qs = 127.0f / am;
        unsigned* o4 = (unsigned*)(o + (size_t)row * D) + lane;
#pragma unroll
        for (int j = 0; j < 8; ++j) o4[64 * j] = pk4_i8(v[j][0] * qs, v[j][1] * qs, v[j][2] * qs, v[j][3] * qs);
        if (lane == 0) xs[row] = am * (1.0f / 127.0f);
    }
}
__device__ __forceinline__ void win8_phase(LAS unsigned char* lds, const float* __restrict__ W, unsigned char* __restrict__ WT, float* __restrict__ wsc, int K, int N, int Npad, int wg, int G) {
    const int tid = tid_opaque(), nn4 = tid & 15, kq = tid >> 4;
    LAS float* pm = (LAS float*)(lds + 32768); LAS float* qsv = (LAS float*)(lds + 32768 + 8192);
    for (int task = wg; task < Npad / 64; task += G) {
        const int n0 = task * 64; const bool inb = (n0 + nn4 * 4 + 3 < N);
        f32x4 m4 = (f32x4){0.f, 0.f, 0.f, 0.f};
        const float* src = W + (size_t)(kq * 64) * N + n0 + nn4 * 4;
#pragma unroll 8
        for (int r = 0; r < 64; ++r) { f32x4 v = (f32x4){0.f, 0.f, 0.f, 0.f}; if (inb) v = *(const f32x4*)(src + (size_t)r * N);
            m4[0] = fmaxf(m4[0], fabsf(v[0])); m4[1] = fmaxf(m4[1], fabsf(v[1])); m4[2] = fmaxf(m4[2], fabsf(v[2])); m4[3] = fmaxf(m4[3], fabsf(v[3])); }
        __syncthreads();
        *(LAS f32x4*)(pm + kq * 64 + nn4 * 4) = m4;
        __syncthreads();
        if (tid < 64) { float cm = 0.f;
#pragma unroll
            for (int q = 0; q < 32; ++q) cm = fmaxf(cm, pm[q * 64 + tid]);
            qsv[tid] = cm > 0.f ? 127.0f / cm : 0.f; wsc[n0 + tid] = cm * (1.0f / 127.0f); }
        __syncthreads();
        const f32x4 qs = *(const LAS f32x4*)(qsv + nn4 * 4);
#pragma unroll 1
        for (int kb = 0; kb < K / 256; ++kb) {
            f32x4 v[8];
            const float* s2 = W + (size_t)(kb * 256 + kq * 8) * N + n0 + nn4 * 4;
#pragma unroll
            for (int r = 0; r < 8; ++r) { v[r] = (f32x4){0.f, 0.f, 0.f, 0.f}; if (inb) v[r] = *(const f32x4*)(s2 + (size_t)r * N); }
#pragma unroll
            for (int g = 0; g < 2; ++g)
#pragma unroll
                for (int j = 0; j < 4; ++j)
                    *(LAS unsigned*)(lds + (nn4 * 4 + j) * 272 + kq * 8 + g * 4) = pk4_i8(v[4 * g][j] * qs[j], v[4 * g + 1][j] * qs[j], v[4 * g + 2][j] * qs[j], v[4 * g + 3][j] * qs[j]);
            __syncthreads();
#pragma unroll
            for (int i = 0; i < 2; ++i) { const int pc = tid + 512 * i, row = pc >> 4, sg = pc & 15;
                *(u32x4*)(WT + (size_t)(n0 + row) * K + kb * 256 + sg * 16) = *(const LAS u32x4*)(lds + row * 272 + sg * 16); }
            __syncthreads();
        }
    }
}
__device__ __forceinline__ void wb_phase(const float* nw, const float* wr, float* WB, int wg, int G) {
    const int tid = tid_opaque();
    for (int o = wg * 512 + tid; o < D * NE; o += G * 512) { const int i = o & 3, e = (o >> 2) & 31, kq = (o >> 7) & 3, jj = o >> 9, k = 16 * jj + 4 * kq + i; WB[o] = nw[k] * wr[k * NE + e]; }
}
__device__ __forceinline__ void router_phase(LAS unsigned char* lds, const bf16_t* h, const float* nw, const float* WB, const float* br, unsigned char* u, float* rstd, int* topi, float* gate, int* lrank, int* cnt, int wg, int G, bool count) {
    const int tid = tid_opaque(), wave = __builtin_amdgcn_readfirstlane(tid >> 6), lane = tid & 63, qq = lane & 15, kq = lane >> 4;
    LAS int* lh = (LAS int*)(lds + 65536);
    if (tid < 32) lh[tid] = 0;
    if (wg == 0) ((unsigned*)(u + (size_t)T * D))[tid] = 0u;
#define RT_STAGE(ch_) do { _Pragma("unroll") for (int i_ = 0; i_ < 4; ++i_) \
        __builtin_amdgcn_global_load_lds((const unsigned*)(WB + (size_t)(ch_) * 8192 + (i_ * 512 + tid) * 4), (LAS unsigned*)(lds + ((ch_) & 1) * 32768 + i_ * 8192 + wave * 1024), 16, 0, 0); } while (0)
    RT_STAGE(0);
    for (int i = tid; i < D; i += 512) *(LAS float*)(lds + 65536 + 256 + i * 4) = nw[i];
    const int task = wg * 4 + (wave & 3);
    const int tok = task * 16 + qq;
    const bf16_t* hp = h + (size_t)tok * D + 4 * kq;
    unsigned* up = (unsigned*)(u + (size_t)tok * D + 4 * kq);
    f32x4 acc0 = (f32x4){0.f, 0.f, 0.f, 0.f}, acc1 = acc0; float ssq = 0.f;
    u32x2 hA[16], hB[16];
#define RT_HLOAD(dst, ch_) do { _Pragma("unroll") for (int j2 = 0; j2 < 16; ++j2) dst[j2] = *(const u32x2*)(hp + 16 * ((ch_) * 16 + j2)); } while (0)
#define RT_COMPUTE(src, ch_) do { const LAS unsigned char* bp = lds + ((ch_) & 1) * 32768 + (kq * 32 + qq) * 16; const LAS unsigned char* gp = lds + 65536 + 256 + ((ch_) * 256 + 4 * kq) * 4; \
        _Pragma("unroll") for (int j2 = 0; j2 < 16; ++j2) { const int jj = (ch_) * 16 + j2; const f32x4 hv = (f32x4){__uint_as_float(src[j2].x << 16), __uint_as_float(src[j2].x & 0xffff0000u), __uint_as_float(src[j2].y << 16), __uint_as_float(src[j2].y & 0xffff0000u)}, g = *(const LAS f32x4*)(gp + j2 * 64); \
            const f32x4 b0 = *(const LAS f32x4*)(bp + j2 * 2048), b1 = *(const LAS f32x4*)(bp + j2 * 2048 + 256); \
            ssq += (hv[0] * hv[0] + hv[1] * hv[1]) + (hv[2] * hv[2] + hv[3] * hv[3]); \
            up[4 * jj] = pk4_fp8(hv[0] * g[0] * U_SCALE, hv[1] * g[1] * U_SCALE, hv[2] * g[2] * U_SCALE, hv[3] * g[3] * U_SCALE); \
            _Pragma("unroll") for (int i = 0; i < 4; ++i) { acc0 = __builtin_amdgcn_mfma_f32_16x16x4f32(hv[i], b0[i], acc0, 0, 0, 0); acc1 = __builtin_amdgcn_mfma_f32_16x16x4f32(hv[i], b1[i], acc1, 0, 0, 0); } } } while (0)
    if (wave < 4) RT_HLOAD(hA, 0);
#pragma unroll 1
    for (int ch = 0; ch < 8; ch += 2) {
        asm volatile("s_waitcnt vmcnt(0)" ::: "memory");
        __syncthreads();
        RT_STAGE(ch + 1);
        if (wave < 4) { RT_HLOAD(hB, ch + 1); RT_COMPUTE(hA, ch); }
        asm volatile("s_waitcnt vmcnt(0)" ::: "memory");
        __syncthreads();
        if (ch + 2 < 8) RT_STAGE(ch + 2);
        if (wave < 4) { if (ch + 2 < 8) RT_HLOAD(hA, ch + 2); RT_COMPUTE(hB, ch + 1); }
    }
#undef RT_HLOAD
#undef RT_COMPUTE
#undef RT_STAGE
    if (wave < 4) {
        ssq += __shfl_xor(ssq, 16); ssq += __shfl_xor(ssq, 32);
        const float rs = rsqrtf(ssq * (1.0f / D) + 1e-5f);
        if (kq == 0) rstd[tok] = rs;
        const float be0 = br[qq], be1 = br[16 + qq];
#pragma unroll
        for (int r = 0; r < 4; ++r) {
            const float rr = __shfl(rs, 4 * kq + r);
            float v0 = acc0[r] * rr + be0, v1 = acc1[r] * rr + be1;
            float tv[4]; int ti[4];
#pragma unroll
            for (int k = 0; k < 4; ++k) {
                float bv = (v0 >= v1) ? v0 : v1; int bi = (v0 >= v1) ? qq : 16 + qq;
#pragma unroll
                for (int o = 1; o < 16; o <<= 1) { const float ov = __shfl_xor(bv, o); const int oi = __shfl_xor(bi, o); if (ov > bv || (ov == bv && oi < bi)) { bv = ov; bi = oi; } }
                tv[k] = bv; ti[k] = bi; if (bi == qq) v0 = -INFINITY; if (bi == 16 + qq) v1 = -INFINITY;
            }
            if (qq == 0) { const int row = task * 16 + 4 * kq + r;
                const float e1 = __expf(tv[1] - tv[0]), e2 = __expf(tv[2] - tv[0]), e3 = __expf(tv[3] - tv[0]); const float inv = 1.0f / (1.0f + e1 + e2 + e3);
                *(f32x4*)(gate + row * 4) = (f32x4){inv, e1 * inv, e2 * inv, e3 * inv};
                *(v4i_t*)(topi + row * 4) = (v4i_t){ti[0], ti[1], ti[2], ti[3]};
                if (count) { v4i_t lr;
#pragma unroll
                    for (int k = 0; k < 4; ++k) lr[k] = __hip_atomic_fetch_add(lh + ti[k], 1, __ATOMIC_RELAXED, __HIP_MEMORY_SCOPE_WORKGROUP);
                    *(v4i_t*)(lrank + row * 4) = lr; } }
        }
    }
    __syncthreads();
    if (count && tid < 32) cnt[wg * 32 + tid] = lh[tid];
}
__device__ __forceinline__ void place_scatter_phase(LAS unsigned char* lds, const int* cnt, const int* topi, const int* lrank, const float* rstd, int* rowtok,
                                                    float* rowscale, int* dest, unsigned* ctl, int wg, int G) {
    const int tid = tid_opaque(), wave = __builtin_amdgcn_readfirstlane(tid >> 6), lane = tid & 63;
    LAS int* sa = (LAS int*)lds;
    {   const int e = tid & 31, part = tid >> 5; int s_all = 0, s_bef = 0;
#pragma unroll
        for (int w2 = part * 16; w2 < part * 16 + 16; ++w2) { const int c = cnt[w2 * 32 + e]; s_all += c; s_bef += (w2 < wg) ? c : 0; }
        sa[part * 32 + e] = s_all; sa[512 + part * 32 + e] = s_bef; }
    __syncthreads();
    if (tid < 32) { int t = 0, b = 0;
#pragma unroll
        for (int part = 0; part < 16; ++part) { t += sa[part * 32 + tid]; b += sa[512 + part * 32 + tid]; }
        sa[1024 + tid] = t; sa[1056 + tid] = b; }
    __syncthreads();
    if (tid == 0) { int acc = 0; for (int e = 0; e < NE; ++e) { sa[1088 + e] = acc; const int nb = (sa[1024 + e] + 255) / 256;
            if (wg == 0) { for (int b = 0; b < nb; ++b) ctl[CW_BLKE + acc / 256 + b] = (unsigned)e; }
            acc += nb * 256; }
        if (wg == 0) ctl[CW_NBLK] = (unsigned)(acc / 256); }
    __syncthreads();
    if (tid < 256) { const int a = wg * 256 + tid, tok = a >> 2, e = topi[a], d = sa[1088 + e] + sa[1056 + e] + lrank[a];
        dest[a] = d; rowtok[d] = tok; rowscale[d] = rstd[tok]; }
    {   const int e = wg & 31, first = sa[1088 + e] + sa[1024 + e], last = sa[1088 + e] + ((sa[1024 + e] + 255) / 256) * 256;
        for (int row = first + (wg >> 5) * 512 + tid; row < last; row += (G >> 5) * 512) { rowtok[row] = T; rowscale[row] = 0.f; } }
}
__device__ __forceinline__ void combine_phase(const bf16_t* h, const unsigned char* y, const int* dest, const float* gate, float* out, int wg, int G) {
    const int tid = tid_opaque(), wave = tid >> 6, lane = tid & 63;
    for (int row = wg * NWAVES + wave; row < T; row += G * NWAVES) {
        int d[4]; float g[4];
#pragma unroll
        for (int k = 0; k < 4; ++k) { d[k] = dest[row * 4 + k]; g[k] = gate[row * 4 + k]; }
#pragma unroll
        for (int j = 0; j < 4; ++j) {
            const int c = (64 * j + lane) * 8;
            const u32x4 hw = *(const u32x4*)(h + (size_t)row * D + c);
            float o[8]; unpack8(hw, o);
#pragma unroll
            for (int k = 0; k < 4; ++k) { const u32x2 w = *(const u32x2*)(y + (size_t)d[k] * D + c); const float gk = g[k] * (1.0f / Y_SCALE);
                const pg8::f32v2_t p0 = __builtin_amdgcn_cvt_pk_f32_fp8((int)w.x, false), p1 = __builtin_amdgcn_cvt_pk_f32_fp8((int)w.x, true), p2 = __builtin_amdgcn_cvt_pk_f32_fp8((int)w.y, false), p3 = __builtin_amdgcn_cvt_pk_f32_fp8((int)w.y, true);
                o[0] += gk * p0[0]; o[1] += gk * p0[1]; o[2] += gk * p1[0]; o[3] += gk * p1[1]; o[4] += gk * p2[0]; o[5] += gk * p2[1]; o[6] += gk * p3[0]; o[7] += gk * p3[1]; }
            __builtin_nontemporal_store(((f32x4){o[0], o[1], o[2], o[3]}), (f32x4*)(out + (size_t)row * D + c)); __builtin_nontemporal_store(((f32x4){o[4], o[5], o[6], o[7]}), (f32x4*)(out + (size_t)row * D + c + 4));
        }
    }
}

__global__ void __launch_bounds__(512, 2) mega_fwd(Ptrs p) {
    extern __shared__ __attribute__((aligned(16))) unsigned char lds_raw[];
    LAS unsigned char* lds = (LAS unsigned char*)lds_raw;
    const int tid = tid_opaque(), wg = (int)blockIdx.x, G = (int)gridDim.x;
    unsigned char* ws = p.ws;
    unsigned* ctl = (unsigned*)(ws + WS_CTL);
    bf16_t *winT = (bf16_t*)(ws + WS_WINT), *woutT = (bf16_t*)(ws + WS_WOUTT); unsigned char *wguT = ws + WS_WGUT, *wdT = ws + WS_WDT;
    bf16_t *xn = (bf16_t*)(ws + WS_XN), *proj = (bf16_t*)(ws + WS_PROJ), *mixed = (bf16_t*)(ws + WS_MIXED);
    unsigned char *u = ws + WS_U, *xg = ws + WS_XG, *act = ws + WS_ACT, *y = ws + WS_Y;
    float *beta = (float*)(ws + WS_BETA), *gdec = (float*)(ws + WS_GDEC), *gate = (float*)(ws + WS_GATE); bf16_t* h = (bf16_t*)(ws + WS_H);
    int *topi = (int*)(ws + WS_TOPI), *dest = (int*)(ws + WS_DEST), *lrank = (int*)(ws + WS_LRANK), *cnt = (int*)(ws + WS_CNT); float* rowscale = (float*)(ws + WS_ROWTOK);
    int* rowtok = (int*)(ws + WS_RTOK);
    float *WB = (float*)(ws + WS_WB), *rstd = (float*)(ws + WS_RSTD), *xsc = (float*)(ws + WS_XS), *wsc = (float*)(ws + WS_WSC);
    bf16_t *NEGW = (bf16_t*)(ws + WS_NEGW), *QG = (bf16_t*)(ws + WS_QG), *KDT = (bf16_t*)(ws + WS_KDT), *UT = (bf16_t*)(ws + WS_UT), *AM = (bf16_t*)(ws + WS_AM); float* GLAST = (float*)(ws + WS_GLAST);

    if (tid < 4) ((LAS unsigned*)(lds + XB_OFF))[tid] = 0u;
    __syncthreads();
    XcdBarrier bar = xcd_barrier_post(ctl, (volatile LAS unsigned*)(lds + XB_OFF));

    {
    win8_phase(lds, p.w_in, (unsigned char*)winT, wsc, D, INW, INP, wg, G);
    wT_phase<0>(lds, p.w_out, woutT, D, D, D, 1, wg, G);
    rms8_phase(p.x, p.attn_norm_w, (unsigned char*)xn, xsc, 1e-5f, wg, G);
    wb_phase(p.ffn_norm_w, p.w_router, WB, wg, G);
    wT8_phase<1>(lds, p.w_gate_up, wguT, D, 4096, NE, ctl + CW_TILEQ);
    wT8_phase<0>(lds, p.w_down, wdT, FF, D, NE, ctl + CW_TILEQ + 64);
    xcd_barrier(bar); }
    {   pg8::Gemm g{xn, winT, 0, D, 0}; pg8::EpiInProj E{proj, beta, gdec, p.a_log, p.dt_bias, xsc, wsc};
        pg8::StaticOrder S; S.init(T / 256, INP / 256, G, wg);
        pg8::gemm_phase<pg8::EpiInProj, pg8::StaticOrder, true, false, true>(lds, g, S, E);
    xcd_barrier(bar); }
    {
    constexpr int NSPLIT = 20, ATT1 = 192, NSCAN = BATCH * 8;
#pragma unroll 1
    for (int part = 0; part < 2; ++part) {
        if (part == 1 && wg < NSCAN) break;
        gdn::prep_phase(lds, proj, beta, gdec, p.conv_w, NEGW, QG, KDT, AM, UT, GLAST, part ? NSPLIT : 0, part ? 32 - NSPLIT : NSPLIT, part ? wg - NSCAN : wg, part ? G - NSCAN : G);
        if (part == 0) xcd_barrier(bar);
    }
    if (wg < NSCAN) gdn::scan_phase(lds, NEGW, QG, KDT, AM, UT, GLAST, proj, p.dn_norm_w, mixed, wg, NSPLIT, [&]() { xcd_barrier(bar); });
    else {
#pragma unroll 1
        for (int part = 0; part < 2; ++part) {
            att::attn_phase(lds, proj, p.q_norm_w, p.k_norm_w, p.sinks, mixed, part ? ATT1 : 0, part ? att::NITEMS : ATT1, wg - NSCAN, G - NSCAN);
            if (part == 0) xcd_barrier(bar);
        }
    }
    xcd_barrier(bar); }
    {   pg8::Gemm g{mixed, woutT, 0, D, 0}; pg8::EpiOutProj E{p.x, h};
        pg8::StaticOrder S; S.init(T / 256, D / 256, G, wg);
        pg8::gemm_phase<pg8::EpiOutProj, pg8::StaticOrder, true>(lds, g, S, E);
    xcd_barrier(bar); }
    {
    router_phase(lds, h, p.ffn_norm_w, WB, p.b_router, u, rstd, topi, gate, lrank, cnt, wg, G, true);
    xcd_barrier(bar); }
    {
    place_scatter_phase(lds, cnt, topi, lrank, rstd, rowtok, rowscale, dest, ctl, wg, G);
    xcd_barrier(bar); }
    {   pg8::Gemm g{u, wguT, (size_t)4096 * D, D, 0}; pg8::EpiSwiGLU E{act, p.b_gate_up, rowscale};
        pg8::MoeOrder S; S.init((int)xb_ld(&ctl[CW_NBLK]), 4096 / 256, G, wg); S.blke = (const int*)(ctl + CW_BLKE); S.rowtok = rowtok;
        pg8::gemm_phase<pg8::EpiSwiGLU, pg8::MoeOrder, true, true, false, true>(lds, g, S, E);
    xcd_barrier(bar); }
    {   pg8::Gemm g{act, wdT, (size_t)D * FF, FF, 0}; pg8::EpiDown E{y, p.b_down};
        pg8::MoeOrder S; S.init((int)xb_ld(&ctl[CW_NBLK]), D / 256, G, wg); S.blke = (const int*)(ctl + CW_BLKE); S.rowtok = rowtok;
        pg8::gemm_phase<pg8::EpiDown, pg8::MoeOrder, true, true>(lds, g, S, E);
    xcd_barrier(bar); }
    combine_phase(h, y, dest, gate, p.out, wg, G);
}

extern "C" void kernel_launch(void* const* d_in, const int* in_sizes, int n_in, void* d_out, int out_size, void* d_ws, size_t ws_size, hipStream_t stream) {
    static int grid = 0;
    if (grid == 0) {
        if (n_in != 18 || in_sizes[0] != T * D || out_size != T * D || ws_size < WS_END) { fprintf(stderr, "kernel_launch: unexpected shapes (n_in %d, in0 %d, out %d, ws %zu < %zu)\n", n_in, n_in > 0 ? in_sizes[0] : -1, out_size, ws_size, (size_t)WS_END); grid = -1; return; }
        int dev = 0, cus = 0, per_cu = 0;
        if (hipGetDevice(&dev) != hipSuccess || hipDeviceGetAttribute(&cus, hipDeviceAttributeMultiprocessorCount, dev) != hipSuccess) { grid = -1; return; }
        if (hipFuncSetAttribute((const void*)mega_fwd, hipFuncAttributeMaxDynamicSharedMemorySize, LDS_BYTES) != hipSuccess) { fprintf(stderr, "kernel_launch: hipFuncSetAttribute failed\n"); grid = -1; return; }
        if (hipOccupancyMaxActiveBlocksPerMultiprocessor(&per_cu, (const void*)mega_fwd, 512, LDS_BYTES) != hipSuccess || per_cu < 1) { fprintf(stderr, "kernel_launch: occupancy query says %d\n", per_cu); grid = -1; (void)hipGetLastError(); return; }
        grid = cus;
        if (grid != 256 || T != 64 * grid) { fprintf(stderr, "kernel_launch: built for a 256-CU device (got %d)\n", grid); grid = -1; return; }
    }
    if (grid < 0) return;
    Ptrs p{};
    const float** pf = (const float**)&p;
    for (int i = 0; i < 18; ++i) pf[i] = (const float*)d_in[i];
    p.out = (float*)d_out; p.ws = (unsigned char*)d_ws;
    (void)hipMemsetAsync((unsigned char*)d_ws + WS_CTL, 0, 128u << 10, stream);
    hipLaunchKernelGGL(mega_fwd, dim3(grid), dim3(512), LDS_BYTES, stream, p);
}
```

```cpp
#include <hip/hip_runtime.h>
#include <cstdio>
#include <cstdint>

constexpr int BATCH = 8, SEQ = 2048, T = BATCH * SEQ, D = 2048;
constexpr int INW = 5648, INP = 5888, PROJW = 5632;
constexpr int C_AQ = 0, C_AK = 1024, C_AV = 1280, C_DQ = 1536, C_DK = 2560, C_DV = 3584, C_DZ = 4608;
constexpr int NE = 32, TOPK = 4, FF = 2048;
constexpr int NASSIGN = T * TOPK;
constexpr int MAXBLK = NASSIGN / 256 + NE;
constexpr int P = MAXBLK * 256;

typedef unsigned short bf16_t;
typedef short bf16x8 __attribute__((ext_vector_type(8)));
typedef float f32x4 __attribute__((ext_vector_type(4)));
typedef unsigned u32x4 __attribute__((ext_vector_type(4)));
typedef unsigned u32x2 __attribute__((ext_vector_type(2)));
typedef int v4i_t __attribute__((ext_vector_type(4)));
typedef int v8i_t __attribute__((ext_vector_type(8)));

constexpr size_t al256(size_t x) { return (x + 255) & ~(size_t)255; }
constexpr size_t WS_CTL = 0, CTL_BYTES = 1u << 20;
constexpr size_t WS_WINT = WS_CTL + CTL_BYTES;
constexpr size_t WS_WOUTT = WS_WINT + al256((size_t)INP * D * 2);
constexpr size_t WS_WGUT = WS_WOUTT + al256((size_t)D * D * 2);
constexpr size_t WS_WDT = WS_WGUT + al256((size_t)NE * 4096 * D * 2);
constexpr size_t WS_XN = WS_WDT + al256((size_t)NE * D * FF * 2);
constexpr size_t WS_PROJ = WS_XN + al256((size_t)T * D * 2);
constexpr size_t WS_BETA = WS_PROJ + al256((size_t)T * PROJW * 2);
constexpr size_t WS_GDEC = WS_BETA + al256((size_t)T * 8 * 4);
constexpr size_t WS_MIXED = WS_GDEC + al256((size_t)T * 8 * 4);
constexpr size_t WS_H = WS_MIXED + al256((size_t)T * D * 2);
constexpr size_t WS_U = WS_H + al256((size_t)T * D * 4);
constexpr size_t WS_TOPI = WS_U + al256((size_t)(T + 1) * D * 2);
constexpr size_t WS_GATE = WS_TOPI + al256((size_t)T * 4 * 4);
constexpr size_t WS_DEST = WS_GATE + al256((size_t)T * 4 * 4);
constexpr size_t WS_ROWTOK = WS_DEST + al256((size_t)T * 4 * 4);
constexpr size_t WS_XG = WS_ROWTOK + al256((size_t)P * 4);
constexpr size_t WS_ACT = WS_XG + al256((size_t)P * D * 2);
constexpr size_t WS_Y = WS_ACT + al256((size_t)P * FF * 2);
constexpr size_t WS_QN = WS_Y + al256((size_t)P * D * 2);
constexpr size_t WS_KN = WS_QN + al256((size_t)T * 1024 * 4);
constexpr size_t WS_NEGW = WS_KN + al256((size_t)T * 256 * 4);
constexpr size_t WS_QG = WS_NEGW + (size_t)2048 * 8192 * 2;
constexpr size_t WS_KDT = WS_QG + (size_t)2048 * 8192 * 2;
constexpr size_t WS_UT = WS_KDT + (size_t)2048 * 8192 * 2;
constexpr size_t WS_AM = WS_UT + (size_t)2048 * 8192 * 2;
constexpr size_t WS_GLAST = WS_AM + (size_t)2048 * 4096 * 2;
constexpr size_t WS_WB = WS_GLAST + al256(2048 * 4);
constexpr size_t WS_RSTD = WS_WB + (size_t)D * NE * 4;
constexpr size_t WS_LRANK = WS_RSTD + al256((size_t)(T + 1) * 4);
constexpr size_t WS_CNT = WS_LRANK + al256((size_t)T * 4 * 4);
constexpr size_t WS_RTOK = WS_CNT + al256(256 * 32 * 4);
constexpr size_t WS_XS = WS_RTOK + al256((size_t)P * 4);
constexpr size_t WS_WSC = WS_XS + al256((size_t)T * 4);
constexpr size_t WS_END = WS_WSC + al256(INP * 4);
constexpr int CW_COUNT = 8192;
constexpr int CW_CURSOR = 8192 + 64;
constexpr int CW_PSTART = 8192 + 128;
constexpr int CW_NBLK = 8192 + 192;
constexpr int CW_BLKE = 8192 + 256;
constexpr int WD_TILES = NE * (D / 64) * (FF / 256), WD_EARLY = WD_TILES * 3 / 4;
constexpr int CW_TILEQ = 16384;

__device__ __forceinline__ bf16_t f2bf(float f) { unsigned u = __float_as_uint(f); u += 0x7FFFu + ((u >> 16) & 1u); return (bf16_t)(u >> 16); }
__device__ __forceinline__ float bf2f(bf16_t b) { return __uint_as_float(((unsigned)b) << 16); }
__device__ __forceinline__ unsigned pk2(float lo, float hi) { return (unsigned)f2bf(lo) | ((unsigned)f2bf(hi) << 16); }
__device__ __forceinline__ float wave_sum(float v) {
#pragma unroll
    for (int o = 1; o < 64; o <<= 1) v += __shfl_xor(v, o);
    return v;
}
constexpr float U_SCALE = 16.0f, W_SCALE = 64.0f, ACT_SCALE = 8.0f, Y_SCALE = 16.0f;
__device__ __forceinline__ float clamp448(float x) { return fminf(fmaxf(x, -448.0f), 448.0f); }
__device__ __forceinline__ unsigned pk4_fp8(float a, float b, float c, float d) {
    int w = __builtin_amdgcn_cvt_pk_fp8_f32(clamp448(a), clamp448(b), 0, false); w = __builtin_amdgcn_cvt_pk_fp8_f32(clamp448(c), clamp448(d), w, true); return (unsigned)w; }
__device__ __forceinline__ int tid_opaque() { int t = (int)threadIdx.x; asm volatile("" : "+v"(t)); return t; }
__device__ __forceinline__ float sigmoidf_(float x) { return __builtin_amdgcn_rcpf(1.0f + __builtin_amdgcn_exp2f(-1.4426950408889634f * x)); }
__device__ __forceinline__ float siluf_(float x) { return x * __builtin_amdgcn_rcpf(1.0f + __builtin_amdgcn_exp2f(-1.4426950408889634f * x)); }
__device__ __forceinline__ float softplusf_(float x) { return x > 20.f ? x : log1pf(__expf(x)); }

namespace pg8 {
#define PG8_LAS __attribute__((address_space(3)))
constexpr int BM = 256, BK = 64, HALF = 128, HTB = HALF * BK * 2, STAGE_BYTES = 8 * HTB, NXCD = 8, WGM = 8;
__host__ __device__ __forceinline__ int lds_byte(int r, int c) { const int st = (r >> 4) * 2 + (c >> 5), rr = r & 15, cc = c & 31, ob = rr * 64 + cc * 2; return st * 1024 + (ob ^ (((ob >> 9) & 1) << 5)); }
__host__ __device__ __forceinline__ void stage_rc(int b, int& R, int& C) { const int st = b / 1024, sb = b % 1024, swz = sb ^ (((sb >> 9) & 1) << 5); R = (st >> 1) * 16 + swz / 64; C = (st & 1) * 32 + (swz % 64) / 2; }
__host__ __device__ __forceinline__ int perm32(int rho) { const int n = rho >> 4, i = rho & 15; return 8 * (i >> 2) + 4 * n + (i & 3); }

struct Unit { int pm, pn, pe; };
struct Gemm { const void* A; const void* Bt; size_t bstride; int K; int pad; };

struct StaticOrder {
    int nM, nN, nwg, G, c;
    __device__ void init(int nM_, int nN_, int G_, int c_) { nM = nM_; nN = nN_; nwg = nM * nN; G = G_; c = c_; }
    __device__ bool next(int i, Unit& u) const {
        const long L = (long)i * G + c; if (L >= nwg) return false;
        int wgid = (int)L; { const int q = nwg / NXCD, r = nwg % NXCD, xcd = wgid % NXCD, off = wgid / NXCD; wgid = (xcd < r ? xcd * (q + 1) : r * (q + 1) + (xcd - r) * q) + off; }
        const int nig = WGM * nN, gid = wgid / nig, fm = gid * WGM, gsz = (nM - fm) < WGM ? (nM - fm) : WGM;
        u.pm = fm + ((wgid % nig) % gsz); u.pn = (wgid % nig) / gsz; u.pe = 0; return true;
    }
};
struct MoeOrder : StaticOrder {
    const int* blke; const int* rowtok;
    __device__ bool next(int i, Unit& u) const { if (!StaticOrder::next(i, u)) return false; u.pe = __hip_atomic_load(blke + u.pm, __ATOMIC_RELAXED, __HIP_MEMORY_SCOPE_AGENT); return true; }
};

typedef __bf16 bf16v2_t __attribute__((ext_vector_type(2)));
typedef float f32v2_t __attribute__((ext_vector_type(2)));
__device__ __forceinline__ unsigned cvt_pk_bf16(float lo, float hi) { const f32v2_t v = {lo, hi}; return __builtin_bit_cast(unsigned, __builtin_convertvector(v, bf16v2_t)); }

template <class Epi, class Sched, bool ALIGN_EPI = true, bool FP8 = false, bool I8 = false, bool GATHER = false>
__device__ __forceinline__ void gemm_phase(PG8_LAS unsigned char* lds, const Gemm g, const Sched& S, const Epi& E) {
    const int tid = tid_opaque(), wid = __builtin_amdgcn_readfirstlane(tid >> 6), lane = tid & 63, wr = wid >> 2, wc = wid & 3, fr = lane & 15, fq = lane >> 4;
    const int pitch = (FP8 || I8) ? g.K : 2 * g.K, nt = pitch / 128;
#define PG8_G(r) (((((r) >> 1) & 7)) ^ (((((r) >> 1) & 7) & 2) << 1))
    unsigned voffA[2], voffB[2];
#pragma unroll
    for (int i = 0; i < 2; ++i) { const int o = tid * 16 + i * 8192, R = o >> 7, cp = (o >> 4) & 7, CB = (cp ^ PG8_G(R & 15)) * 16;
        const int Rb = Epi::PERM ? ((R & ~31) + perm32(R & 31)) : R;
        voffA[i] = (unsigned)(R * pitch + CB); voffB[i] = (unsigned)(Rb * pitch + CB); }
    const size_t kstep = (size_t)128;
    const size_t hstep = (size_t)HALF * pitch;
    const size_t tstep = 2 * hstep;
    const unsigned ldsw = (unsigned)wid * 1024u;
    const int c0 = FP8 ? 2 * fq : fq, c1 = FP8 ? 2 * fq + 1 : 4 + fq, gf = PG8_G(fr);
    unsigned ldsA0_u = (unsigned)(size_t)lds + (unsigned)((wr * 64 + fr) * 128 + ((c0 ^ gf) * 16)), ldsA1_u = (unsigned)(size_t)lds + (unsigned)((wr * 64 + fr) * 128 + ((c1 ^ gf) * 16));
    unsigned ldsB0_u = (unsigned)(size_t)lds + 65536u + (unsigned)((wc * 32 + fr) * 128 + ((c0 ^ gf) * 16)), ldsB1_u = (unsigned)(size_t)lds + 65536u + (unsigned)((wc * 32 + fr) * 128 + ((c1 ^ gf) * 16));
    asm volatile("" : "+v"(ldsA0_u), "+v"(ldsA1_u), "+v"(ldsB0_u), "+v"(ldsB1_u));
    const PG8_LAS unsigned char* ldsA0 = (const PG8_LAS unsigned char*)(size_t)ldsA0_u; const PG8_LAS unsigned char* ldsA1 = (const PG8_LAS unsigned char*)(size_t)ldsA1_u;
    const PG8_LAS unsigned char* ldsB0 = (const PG8_LAS unsigned char*)(size_t)ldsB0_u; const PG8_LAS unsigned char* ldsB1 = (const PG8_LAS unsigned char*)(size_t)ldsB1_u;
#undef PG8_G
#define PG8_SA(b, h) (((b) * 2 + (h)) * HTB)
#define PG8_SB(b, h) ((4 + (b) * 2 + (h)) * HTB)
#define PG8_STAGE(bufoff, gbase, voff) do { _Pragma("unroll") for (int _i = 0; _i < 2; ++_i) \
        __builtin_amdgcn_global_load_lds((const unsigned*)((const char*)(gbase) + (voff)[_i]), (PG8_LAS unsigned*)(lds + (bufoff) + ldsw + _i * 8192), 16, 0, 0); } while (0)
#define PG8_LD8(p0, p1, base) __builtin_shufflevector(*(const PG8_LAS v4i_t*)((p0) + (base)), *(const PG8_LAS v4i_t*)((p1) + (base)), 0, 1, 2, 3, 4, 5, 6, 7)
#define PG8_LDA(dst, b, h) do { if constexpr (FP8) { _Pragma("unroll") for (int m = 0; m < 4; ++m) dst##8[m] = PG8_LD8(ldsA0, ldsA1, PG8_SA(b, h) + m * 2048); } \
        else { _Pragma("unroll") for (int m = 0; m < 4; ++m) { dst[m][0] = *(const PG8_LAS bf16x8*)(ldsA0 + PG8_SA(b, h) + m * 2048); dst[m][1] = *(const PG8_LAS bf16x8*)(ldsA1 + PG8_SA(b, h) + m * 2048); } } } while (0)
#define PG8_LDB(dst, b, h) do { if constexpr (FP8) { _Pragma("unroll") for (int n = 0; n < 2; ++n) dst##8[n] = PG8_LD8(ldsB0, ldsB1, PG8_SB(b, h) - 65536 + n * 2048); } \
        else { _Pragma("unroll") for (int n = 0; n < 2; ++n) { dst[n][0] = *(const PG8_LAS bf16x8*)(ldsB0 + PG8_SB(b, h) - 65536 + n * 2048); dst[n][1] = *(const PG8_LAS bf16x8*)(ldsB1 + PG8_SB(b, h) - 65536 + n * 2048); } } } while (0)
#define PG8_MMA(ai, bj, At, Bt) do { __builtin_amdgcn_s_setprio(1); \
        if constexpr (FP8) { _Pragma("unroll") for (int m = 0; m < 4; ++m) _Pragma("unroll") for (int n = 0; n < 2; ++n) \
            asm volatile("v_mfma_scale_f32_16x16x128_f8f6f4 %0, %1, %2, %0, %3, %3 op_sel_hi:[0,0,0]" : "+v"(acc[ai][bj][m][n]) : "v"(Bt##8[n]), "v"(At##8[m]), "v"(one_scale)); } \
        else if constexpr (I8) { _Pragma("unroll") for (int m = 0; m < 4; ++m) _Pragma("unroll") for (int n = 0; n < 2; ++n) _Pragma("unroll") for (int k = 0; k < 2; ++k) \
            acc[ai][bj][m][n] = __builtin_bit_cast(f32x4, __builtin_amdgcn_mfma_i32_16x16x64_i8(__builtin_bit_cast(v4i_t, Bt[n][k]), __builtin_bit_cast(v4i_t, At[m][k]), __builtin_bit_cast(v4i_t, acc[ai][bj][m][n]), 0, 0, 0)); } \
        else { _Pragma("unroll") for (int m = 0; m < 4; ++m) _Pragma("unroll") for (int n = 0; n < 2; ++n) _Pragma("unroll") for (int k = 0; k < 2; ++k) \
            acc[ai][bj][m][n] = __builtin_amdgcn_mfma_f32_16x16x32_bf16(Bt[n][k], At[m][k], acc[ai][bj][m][n], 0, 0, 0); } \
        __builtin_amdgcn_s_setprio(0); } while (0)
#define PG8_WAIT_V(n) asm volatile("s_waitcnt vmcnt(" #n ")" ::: "memory")
#define PG8_WAIT_L(n) asm volatile("s_waitcnt lgkmcnt(" #n ")" ::: "memory")
#define PG8_BAR __builtin_amdgcn_s_barrier()
#define PG8_SCHED __builtin_amdgcn_sched_barrier(0)
    const int one_scale = 0x7F7F7F7F;
    Unit cur, nxt; int ui = 0;
    if (!S.next(0, cur)) return;
    f32x4 acc[2][2][4][2];
#pragma unroll
    for (int a = 0; a < 2; ++a)
#pragma unroll
        for (int b = 0; b < 2; ++b)
#pragma unroll
            for (int m = 0; m < 4; ++m)
#pragma unroll
                for (int n = 0; n < 2; ++n) acc[a][b][m][n] = (f32x4){0.f, 0.f, 0.f, 0.f};
    bf16x8 At[4][2], B0[2][2], B1[2][2]; v8i_t At8[4], B08[2], B18[2];
    unsigned vgC[2][2], vgN[2][2];
    PG8_LAS unsigned short* gtab = (PG8_LAS unsigned short*)(lds + STAGE_BYTES);
    const unsigned gcb = (unsigned)(((tid & 7) ^ ((((tid >> 4) & 7)) ^ (((((tid >> 4) & 7)) & 2) << 1))) * 16);
#define PG8_GLOAD(dst, ui_) do { _Pragma("unroll") for (int h_ = 0; h_ < 2; ++h_) _Pragma("unroll") for (int i_ = 0; i_ < 2; ++i_) \
        dst[h_][i_] = (unsigned)gtab[(ui_) * 256 + h_ * 128 + i_ * 64 + (tid >> 3)] * (unsigned)pitch + gcb; } while (0)
    if constexpr (GATHER) {
        Unit uu;
        for (int i = 0; S.next(i, uu); ++i) if (tid < 256) gtab[i * 256 + tid] = (unsigned short)S.rowtok[uu.pm * 256 + tid];
        __syncthreads();
        PG8_GLOAD(vgC, 0);
    }
    const char* cA = GATHER ? (const char*)g.A : (const char*)g.A + (size_t)cur.pm * tstep; const char* cB = (const char*)g.Bt + (size_t)cur.pe * g.bstride + (size_t)cur.pn * tstep;
#define PG8_STAGE_A(b, gb) do { if constexpr (GATHER) { PG8_STAGE(PG8_SA(b, 0), gb, vgC[0]); PG8_STAGE(PG8_SA(b, 1), gb, vgC[1]); } \
        else { PG8_STAGE(PG8_SA(b, 0), gb, voffA); PG8_STAGE(PG8_SA(b, 1), (gb) + hstep, voffA); } } while (0)
    PG8_STAGE(PG8_SB(0, 0), cB, voffB); PG8_STAGE(PG8_SB(0, 1), cB + hstep, voffB); PG8_STAGE_A(0, cA);
    if (wr == 1) PG8_BAR;
    PG8_WAIT_V(2); PG8_BAR;
    PG8_STAGE(PG8_SB(1, 0), cB + kstep, voffB); PG8_STAGE(PG8_SB(1, 1), cB + hstep + kstep, voffB);
    PG8_WAIT_V(4); PG8_BAR;
    for (;;) {
        const bool has_next = S.next(ui + 1, nxt);
        const char* nA = GATHER ? cA : (has_next ? (const char*)g.A + (size_t)nxt.pm * tstep : cA);
        const char* nB = has_next ? (const char*)g.Bt + (size_t)nxt.pe * g.bstride + (size_t)nxt.pn * tstep : cB;
        for (int t = 0; t < nt; t += 2) {
            const bool last = (t == nt - 2);
            const char* a1 = cA + (size_t)(t + 1) * kstep;
            const char* a2 = last ? nA : cA + (size_t)(t + 2) * kstep; const char* b2 = last ? nB : cB + (size_t)(t + 2) * kstep;
            const char* b3 = b2 + kstep;
            if constexpr (GATHER) { if (last) PG8_GLOAD(vgN, has_next ? ui + 1 : ui); }
            PG8_LDB(B0, 0, 0); PG8_LDB(B1, 0, 1); PG8_SCHED; PG8_LDA(At, 0, 0); PG8_STAGE_A(1, a1);
            if constexpr (GATHER) { if (last) {
#pragma unroll
                for (int h_ = 0; h_ < 2; ++h_) { vgC[h_][0] = vgN[h_][0]; vgC[h_][1] = vgN[h_][1]; } } }
            PG8_WAIT_V(8); PG8_WAIT_L(0); PG8_BAR; PG8_MMA(0, 0, At, B0); PG8_MMA(0, 1, At, B1); PG8_BAR; PG8_SCHED;
            PG8_LDA(At, 0, 1); PG8_STAGE(PG8_SB(0, 0), b2, voffB); PG8_STAGE(PG8_SB(0, 1), b2 + hstep, voffB);
            PG8_WAIT_V(6); PG8_WAIT_L(0); PG8_BAR; PG8_MMA(1, 0, At, B0); PG8_MMA(1, 1, At, B1); PG8_BAR; PG8_SCHED;
            PG8_LDB(B0, 1, 0); PG8_LDB(B1, 1, 1); PG8_SCHED; PG8_LDA(At, 1, 0); PG8_STAGE_A(0, a2);
            PG8_WAIT_V(8); PG8_WAIT_L(0); PG8_BAR; PG8_MMA(0, 0, At, B0); PG8_MMA(0, 1, At, B1); PG8_BAR; PG8_SCHED;
            PG8_LDA(At, 1, 1); PG8_STAGE(PG8_SB(1, 0), b3, voffB); PG8_STAGE(PG8_SB(1, 1), b3 + hstep, voffB);
            PG8_WAIT_V(6); PG8_WAIT_L(0); PG8_BAR; PG8_MMA(1, 0, At, B0); PG8_MMA(1, 1, At, B1); PG8_BAR; PG8_SCHED;
        }
        if constexpr (ALIGN_EPI) { if (wr == 0) PG8_BAR; }
        if constexpr (FP8) asm volatile("s_nop 15\n\ts_nop 15" ::: "memory");
        E(acc, cur, wr, wc, fr, fq);
        if (!has_next) break;
#pragma unroll
        for (int a = 0; a < 2; ++a)
#pragma unroll
            for (int b = 0; b < 2; ++b)
#pragma unroll
                for (int m = 0; m < 4; ++m)
#pragma unroll
                    for (int n = 0; n < 2; ++n) acc[a][b][m][n] = (f32x4){0.f, 0.f, 0.f, 0.f};
        cur = nxt; cA = nA; cB = nB; ++ui;
        if constexpr (ALIGN_EPI) { if (wr == 1) PG8_BAR; }
    }
    PG8_WAIT_V(0);
    if constexpr (!ALIGN_EPI) { if (wr == 0) PG8_BAR; }
    PG8_BAR;
#undef PG8_SA
#undef PG8_SB
#undef PG8_STAGE
#undef PG8_STAGE_A
#undef PG8_GLOAD
#undef PG8_LDA
#undef PG8_LDB
#undef PG8_MMA
#undef PG8_LD8
#undef PG8_WAIT_V
#undef PG8_WAIT_L
#undef PG8_BAR
#undef PG8_SCHED
}

struct EpiInProj {
    static constexpr bool PERM = true;
    bf16_t* proj; float* beta; float* gdec; const float* a_log; const float* dt_bias; const float* xs; const float* wsc;
    __device__ __forceinline__ void operator()(const f32x4 (&acc)[2][2][4][2], const Unit& u, int wr, int wc, int fr, int fq) const {
        const int row0 = u.pm * BM + wr * 64 + fr;
        float rsv[2][4];
#pragma unroll
        for (int ai = 0; ai < 2; ++ai)
#pragma unroll
            for (int m = 0; m < 4; ++m) rsv[ai][m] = xs[row0 + ai * HALF + m * 16];
        if (u.pn < PROJW / BM) {
            const int col0 = u.pn * BM + wc * 32 + 8 * fq;
            f32x4 cs[2][2];
#pragma unroll
            for (int bj = 0; bj < 2; ++bj)
#pragma unroll
                for (int n = 0; n < 2; ++n) cs[bj][n] = *(const f32x4*)(wsc + col0 + bj * HALF + 4 * n);
#pragma unroll
            for (int ai = 0; ai < 2; ++ai)
#pragma unroll
                for (int m = 0; m < 4; ++m) { const int row = row0 + ai * HALF + m * 16; const float rs = rsv[ai][m]; bf16_t* rowp = proj + (size_t)row * PROJW + col0;
#pragma unroll
                    for (int bj = 0; bj < 2; ++bj) { const f32x4 v0 = __builtin_convertvector(__builtin_bit_cast(v4i_t, acc[ai][bj][m][0]), f32x4) * rs * cs[bj][0], v1 = __builtin_convertvector(__builtin_bit_cast(v4i_t, acc[ai][bj][m][1]), f32x4) * rs * cs[bj][1];
                        u32x4 w; w.x = cvt_pk_bf16(v0[0], v0[1]); w.y = cvt_pk_bf16(v0[2], v0[3]); w.z = cvt_pk_bf16(v1[0], v1[1]); w.w = cvt_pk_bf16(v1[2], v1[3]);
                        *(u32x4*)(rowp + bj * HALF) = w; } }
        } else if (wc == 0 && fq < 2) {
            const int colb = u.pn * BM + 8 * fq;
#pragma unroll
            for (int ai = 0; ai < 2; ++ai)
#pragma unroll
                for (int m = 0; m < 4; ++m) { const int row = row0 + ai * HALF + m * 16; const float rs = rsv[ai][m];
#pragma unroll
                    for (int n = 0; n < 2; ++n)
#pragma unroll
                        for (int j = 0; j < 4; ++j) { const int hh = 4 * n + j; const float v = (float)__builtin_bit_cast(v4i_t, acc[ai][0][m][n])[j] * rs * wsc[colb + hh];
                            if (fq == 0) beta[(size_t)row * 8 + hh] = sigmoidf_(v);
                            else gdec[(size_t)row * 8 + hh] = -__expf(a_log[hh]) * softplusf_(v + dt_bias[hh]); } }
        }
    }
};
struct EpiOutProj {
    static constexpr bool PERM = false;
    const float* x; bf16_t* h;
    __device__ __forceinline__ void operator()(const f32x4 (&acc)[2][2][4][2], const Unit& u, int wr, int wc, int fr, int fq) const {
        const int row0 = u.pm * BM + wr * 64 + fr, col0 = u.pn * BM + wc * 32 + 4 * fq;
#pragma unroll
        for (int ai = 0; ai < 2; ++ai) {
            f32x4 xv[4][2][2];
#pragma unroll
            for (int m = 0; m < 4; ++m)
#pragma unroll
                for (int bj = 0; bj < 2; ++bj)
#pragma unroll
                    for (int n = 0; n < 2; ++n) xv[m][bj][n] = *(const f32x4*)(x + (size_t)(row0 + ai * HALF + m * 16) * D + col0 + bj * HALF + n * 16);
#pragma unroll
            for (int m = 0; m < 4; ++m) { const size_t off = (size_t)(row0 + ai * HALF + m * 16) * D + col0;
#pragma unroll
                for (int bj = 0; bj < 2; ++bj)
#pragma unroll
                    for (int n = 0; n < 2; ++n) { const f32x4 v = xv[m][bj][n] + acc[ai][bj][m][n];
                        u32x2 w; w.x = cvt_pk_bf16(v[0], v[1]); w.y = cvt_pk_bf16(v[2], v[3]); *(u32x2*)(h + off + bj * HALF + n * 16) = w; } }
        }
    }
};
struct EpiSwiGLU {
    static constexpr bool PERM = true;
    unsigned char* act; const float* bgu; const float* rowscale;
    __device__ __forceinline__ void operator()(const f32x4 (&acc)[2][2][4][2], const Unit& u, int wr, int wc, int fr, int fq) const {
        const int row0 = u.pm * BM + wr * 64 + fr, col0 = u.pn * HALF + wc * 32 + 8 * fq;
        const float* bg = bgu + (size_t)u.pe * 4096 + col0;
        f32x4 bg0 = *(const f32x4*)(bg), bg1 = *(const f32x4*)(bg + 4), bl0 = *(const f32x4*)(bg + 2048), bl1 = *(const f32x4*)(bg + 2048 + 4);
        float rsv[2][4];
#pragma unroll
        for (int ai = 0; ai < 2; ++ai)
#pragma unroll
            for (int m = 0; m < 4; ++m) rsv[ai][m] = rowscale[row0 + ai * HALF + m * 16];
#pragma unroll
        for (int ai = 0; ai < 2; ++ai)
#pragma unroll
            for (int m = 0; m < 4; ++m) {
                const float SC = rsv[ai][m] * (1.0f / (U_SCALE * W_SCALE));
                f32x4 g0 = acc[ai][0][m][0] * SC + bg0, g1 = acc[ai][0][m][1] * SC + bg1, l0 = acc[ai][1][m][0] * SC + bl0, l1 = acc[ai][1][m][1] * SC + bl1;
                float o[8];
#pragma unroll
                for (int j = 0; j < 4; ++j) {
                    float a = fminf(g0[j], 7.0f), b = __builtin_amdgcn_fmed3f(l0[j], -7.0f, 7.0f); o[j] = a * __builtin_amdgcn_rcpf(1.0f + __builtin_amdgcn_exp2f(-2.4554669595930156f * a)) * (b * ACT_SCALE + ACT_SCALE);
                    float c = fminf(g1[j], 7.0f), d = __builtin_amdgcn_fmed3f(l1[j], -7.0f, 7.0f); o[4 + j] = c * __builtin_amdgcn_rcpf(1.0f + __builtin_amdgcn_exp2f(-2.4554669595930156f * c)) * (d * ACT_SCALE + ACT_SCALE); }
                u32x2 w; { int t0_ = __builtin_amdgcn_cvt_pk_fp8_f32(o[0], o[1], 0, false); t0_ = __builtin_amdgcn_cvt_pk_fp8_f32(o[2], o[3], t0_, true); int t1_ = __builtin_amdgcn_cvt_pk_fp8_f32(o[4], o[5], 0, false); t1_ = __builtin_amdgcn_cvt_pk_fp8_f32(o[6], o[7], t1_, true); w.x = (unsigned)t0_; w.y = (unsigned)t1_; }
                *(u32x2*)(act + (size_t)(row0 + ai * HALF + m * 16) * FF + col0) = w; }
    }
};
struct EpiDown {
    static constexpr bool PERM = true;
    unsigned char* y; const float* bd;
    __device__ __forceinline__ void operator()(const f32x4 (&acc)[2][2][4][2], const Unit& u, int wr, int wc, int fr, int fq) const {
        const int row0 = u.pm * BM + wr * 64 + fr, col0 = u.pn * BM + wc * 32 + 8 * fq;
        const float* bp = bd + (size_t)u.pe * D + col0;
        f32x4 bv[2][2];
#pragma unroll
        for (int bj = 0; bj < 2; ++bj)
#pragma unroll
            for (int n = 0; n < 2; ++n) bv[bj][n] = *(const f32x4*)(bp + bj * HALF + 4 * n) * Y_SCALE;
#pragma unroll
        for (int ai = 0; ai < 2; ++ai)
#pragma unroll
            for (int m = 0; m < 4; ++m) { unsigned char* rowp = y + (size_t)(row0 + ai * HALF + m * 16) * D + col0;
#pragma unroll
                for (int bj = 0; bj < 2; ++bj) { constexpr float SC = Y_SCALE / (ACT_SCALE * W_SCALE); const f32x4 v0 = acc[ai][bj][m][0] * SC + bv[bj][0], v1 = acc[ai][bj][m][1] * SC + bv[bj][1];
                    u32x2 w; w.x = pk4_fp8(v0[0], v0[1], v0[2], v0[3]); w.y = pk4_fp8(v1[0], v1[1], v1[2], v1[3]);
                    *(u32x2*)(rowp + bj * HALF) = w; } }
    }
};
}

struct Ptrs {
    const float *x, *attn_norm_w, *w_in, *q_norm_w, *k_norm_w, *sinks, *conv_w, *a_log, *dt_bias, *dn_norm_w, *w_out, *ffn_norm_w, *w_router, *b_router, *w_gate_up, *b_gate_up, *w_down, *b_down;
    float* out; unsigned char* ws;
};

#define LAS __attribute__((address_space(3)))
__device__ __forceinline__ bf16x8 pack8(float a0, float a1, float a2, float a3, float a4, float a5, float a6, float a7) {
    u32x4 w; w.x = pg8::cvt_pk_bf16(a0, a1); w.y = pg8::cvt_pk_bf16(a2, a3); w.z = pg8::cvt_pk_bf16(a4, a5); w.w = pg8::cvt_pk_bf16(a6, a7);
    return __builtin_bit_cast(bf16x8, w);
}
__device__ __forceinline__ void unpack8(const u32x4 w, float (&f)[8]) {
    f[0] = __uint_as_float(w.x << 16); f[1] = __uint_as_float(w.x & 0xffff0000u); f[2] = __uint_as_float(w.y << 16); f[3] = __uint_as_float(w.y & 0xffff0000u);
    f[4] = __uint_as_float(w.z << 16); f[5] = __uint_as_float(w.z & 0xffff0000u); f[6] = __uint_as_float(w.w << 16); f[7] = __uint_as_float(w.w & 0xffff0000u);
}
#define MFMA16(a, b, c) __builtin_amdgcn_mfma_f32_16x16x32_bf16((a), (b), (c), 0, 0, 0)

namespace att {
constexpr int KS_STRIDE = 144, VT_STRIDE = 528;
constexpr int KS_OFF = 0, VT_OFF = 256 * KS_STRIDE, LDS_BYTES = VT_OFF + 64 * VT_STRIDE;
constexpr int NITEMS = BATCH * 16 * 4;
__device__ __forceinline__ void attn_phase(LAS unsigned char* lds, const bf16_t* __restrict__ proj, const float* __restrict__ qw, const float* __restrict__ kw, const float* __restrict__ sinks,
                                           bf16_t* __restrict__ mixed, int lo, int hi, int first, int stride) {
    const int tid = tid_opaque(), w = __builtin_amdgcn_readfirstlane(tid >> 6), lane = tid & 63, qq = lane & 15, kq = lane >> 4;
    float mq = 0.f, mk = 0.f, ms = -1e30f;
    for (int d = 0; d < 64; ++d) { mq = fmaxf(mq, fabsf(qw[d])); mk = fmaxf(mk, fabsf(kw[d])); }
    for (int h = 0; h < 16; ++h) ms = fmaxf(ms, sinks[h]);
    const float L2E = 1.4426950408889634f;
    const float m02 = fmaxf(8.0f * mq * mk, ms) * L2E;
    for (int item = lo + first; item < hi; item += stride) {
        const int kvh = item & 3, qb = (item >> 2) & 15, b = item >> 6;
        const int h = kvh * 4 + (w >> 1), qhalf = w & 1;
        const long tok0 = (long)b * SEQ + (qb - 1) * 128;
        u32x4 qr0[4], qr1[4];
#pragma unroll
        for (int qt = 0; qt < 4; ++qt) { const bf16_t* rp = proj + ((size_t)b * SEQ + qb * 128 + qhalf * 64 + qt * 16 + qq) * PROJW + C_AQ + h * 64 + kq * 8; qr0[qt] = *(const u32x4*)rp; qr1[qt] = *(const u32x4*)(rp + 32); }
        __syncthreads();
        const int tidl = tid_opaque();
        float kwr[8];
#pragma unroll
        for (int j = 0; j < 8; ++j) kwr[j] = kw[(tidl & 7) * 8 + j];
#pragma unroll
        for (int i = 0; i < 4; ++i) {
            const int piece = tidl + 512 * i, key = piece >> 3, dseg = piece & 7; const bool valid = (qb > 0) || (key >= 128);
            u32x4 kr = (u32x4){0u, 0u, 0u, 0u}, vr = (u32x4){0u, 0u, 0u, 0u};
            if (valid) { const bf16_t* rp = proj + (size_t)(tok0 + key) * PROJW + kvh * 64 + dseg * 8; kr = *(const u32x4*)(rp + C_AK); vr = *(const u32x4*)(rp + C_AV); }
            float kf[8]; unpack8(kr, kf);
            float ss = 0.f;
#pragma unroll
            for (int j = 0; j < 8; ++j) ss += kf[j] * kf[j];
            ss += __shfl_xor(ss, 1); ss += __shfl_xor(ss, 2); ss += __shfl_xor(ss, 4);
            const float r = rsqrtf(ss * (1.0f / 64.0f) + 1e-6f);
            *(LAS bf16x8*)(lds + KS_OFF + key * KS_STRIDE + dseg * 16) = pack8(kf[0] * r * kwr[0], kf[1] * r * kwr[1], kf[2] * r * kwr[2], kf[3] * r * kwr[3], kf[4] * r * kwr[4], kf[5] * r * kwr[5], kf[6] * r * kwr[6], kf[7] * r * kwr[7]);
            const unsigned vw[4] = {vr.x, vr.y, vr.z, vr.w};
            const int ks = key ^ (dseg << 3);
#pragma unroll
            for (int j = 0; j < 8; ++j) *(LAS bf16_t*)(lds + VT_OFF + (dseg * 8 + j) * VT_STRIDE + ks * 2) = (bf16_t)((j & 1) ? (vw[j >> 1] >> 16) : (vw[j >> 1] & 0xffffu));
        }
        __syncthreads();
        bf16x8 Qf[4][2];
        {   float qw0[8], qw1[8];
#pragma unroll
            for (int j = 0; j < 8; ++j) { qw0[j] = qw[kq * 8 + j]; qw1[j] = qw[32 + kq * 8 + j]; }
#pragma unroll
            for (int qt = 0; qt < 4; ++qt) {
                float x0[8], x1[8]; unpack8(qr0[qt], x0); unpack8(qr1[qt], x1);
                float ss = 0.f;
#pragma unroll
                for (int j = 0; j < 8; ++j) ss += x0[j] * x0[j] + x1[j] * x1[j];
                ss += __shfl_xor(ss, 16); ss += __shfl_xor(ss, 32);
                const float r = rsqrtf(ss * (1.0f / 64.0f) + 1e-6f) * 0.125f * L2E;
                Qf[qt][0] = pack8(x0[0] * r * qw0[0], x0[1] * r * qw0[1], x0[2] * r * qw0[2], x0[3] * r * qw0[3], x0[4] * r * qw0[4], x0[5] * r * qw0[5], x0[6] * r * qw0[6], x0[7] * r * qw0[7]);
                Qf[qt][1] = pack8(x1[0] * r * qw1[0], x1[1] * r * qw1[1], x1[2] * r * qw1[2], x1[3] * r * qw1[3], x1[4] * r * qw1[4], x1[5] * r * qw1[5], x1[6] * r * qw1[6], x1[7] * r * qw1[7]);
            }
        }
        f32x4 O[4][4]; float lsum[4];
#pragma unroll
        for (int qt = 0; qt < 4; ++qt) { lsum[qt] = 0.f;
#pragma unroll
            for (int dt = 0; dt < 4; ++dt) O[qt][dt] = (f32x4){0.f, 0.f, 0.f, 0.f}; }
        const float sl2 = exp2f(-0.5f * (float)(h + 1)) * L2E;
        const int vsw = (qq >> 3) << 3;
#pragma unroll 1
        for (int kt3 = 0; kt3 < 3; ++kt3) {
            const int kt = qhalf + kt3;
#pragma unroll 1
            for (int sp = 0; sp < 2; ++sp) {
                bf16x8 Kf[2][2]; u32x2 Vr[4][2];
#pragma unroll
                for (int h2 = 0; h2 < 2; ++h2) { const int krow = kt * 64 + (2 * sp + h2) * 16 + qq;
                    Kf[h2][0] = *(const LAS bf16x8*)(lds + KS_OFF + krow * KS_STRIDE + kq * 16); Kf[h2][1] = *(const LAS bf16x8*)(lds + KS_OFF + krow * KS_STRIDE + 64 + kq * 16); }
#pragma unroll
                for (int dt = 0; dt < 4; ++dt) { const int off0 = ((kt * 64 + 32 * sp + 4 * kq) ^ ((dt << 4) | vsw)) * 2;
                    const LAS unsigned char* vp = lds + VT_OFF + (dt * 16 + qq) * VT_STRIDE;
                    Vr[dt][0] = *(const LAS u32x2*)(vp + off0); Vr[dt][1] = *(const LAS u32x2*)(vp + (off0 ^ 32)); }
                u32x2 Ph[4][2];
#pragma unroll
                for (int h2 = 0; h2 < 2; ++h2) {
#pragma unroll
                    for (int qt = 0; qt < 4; ++qt) {
                        f32x4 a = MFMA16(Kf[h2][0], Qf[qt][0], ((f32x4){0.f, 0.f, 0.f, 0.f})); a = MFMA16(Kf[h2][1], Qf[qt][1], a);
                        float p[4];
#pragma unroll
                        for (int r = 0; r < 4; ++r) {
                            const int ki = kt * 64 + (2 * sp + h2) * 16 + 4 * kq + r, qi = qhalf * 64 + qt * 16 + qq, dist = 128 + qi - ki;
                            const bool valid = ((unsigned)dist < 128u) && ((qb > 0) || (ki >= 128));
                            const float e = __builtin_amdgcn_exp2f(a[r] - sl2 * (float)dist - m02);
                            p[r] = valid ? e : 0.f; lsum[qt] += p[r];
                        }
                        Ph[qt][h2].x = pg8::cvt_pk_bf16(p[0], p[1]); Ph[qt][h2].y = pg8::cvt_pk_bf16(p[2], p[3]);
                    }
                }
#pragma unroll
                for (int dt = 0; dt < 4; ++dt) {
                    const bf16x8 Vf = __builtin_bit_cast(bf16x8, ((u32x4){Vr[dt][0].x, Vr[dt][0].y, Vr[dt][1].x, Vr[dt][1].y}));
#pragma unroll
                    for (int qt = 0; qt < 4; ++qt) O[qt][dt] = MFMA16(Vf, __builtin_bit_cast(bf16x8, ((u32x4){Ph[qt][0].x, Ph[qt][0].y, Ph[qt][1].x, Ph[qt][1].y})), O[qt][dt]);
                }
            }
        }
        const float es = __builtin_amdgcn_exp2f(sinks[h] * L2E - m02);
#pragma unroll
        for (int qt = 0; qt < 4; ++qt) {
            float l = lsum[qt]; l += __shfl_xor(l, 16); l += __shfl_xor(l, 32);
            const float inv = __builtin_amdgcn_rcpf(l + es);
            bf16_t* op = mixed + ((size_t)b * SEQ + qb * 128 + qhalf * 64 + qt * 16 + qq) * D + h * 64 + 4 * kq;
#pragma unroll
            for (int dt = 0; dt < 4; ++dt) { u32x2 w2; w2.x = pg8::cvt_pk_bf16(O[qt][dt][0] * inv, O[qt][dt][1] * inv); w2.y = pg8::cvt_pk_bf16(O[qt][dt][2] * inv, O[qt][dt][3] * inv); *(u32x2*)(op + dt * 16) = w2; }
        }
    }
}
}
namespace gdn {
constexpr int NITEMS = BATCH * 32 * 8;
constexpr int KS_OFF = 0, QS_OFF = KS_OFF + 64 * 272, KBT_OFF = QS_OFF + 64 * 272, VBT_OFF = KBT_OFF + 128 * 144, PB_OFF = VBT_OFF + 128 * 144;
constexpr int PBUF = 27648, KDT_OFF = PB_OFF + PBUF;
constexpr int GC_OFF = PB_OFF + 2 * PBUF, BT_OFF = GC_OFF + 256, CW_OFF = BT_OFF + 256, PREP_LDS = CW_OFF + 6144;
constexpr int SC_BUF = 57344, SC_OT_OFF = 2 * SC_BUF, SC_OT_STRIDE = 528, SC_NW_OFF = SC_OT_OFF + 64 * SC_OT_STRIDE, SCAN_LDS = SC_NW_OFF + 512;

__device__ __forceinline__ u32x2 pack4(float a, float b, float c, float d) { u32x2 r; r.x = pg8::cvt_pk_bf16(a, b); r.y = pg8::cvt_pk_bf16(c, d); return r; }

__device__ __forceinline__ void conv_load(const bf16_t* __restrict__ proj, size_t t0, int c, int n, int colbase, u32x4 (&r)[4][2]) {
#pragma unroll
    for (int tap = 0; tap < 4; ++tap) {
        const int tr = c - 3 + tap;
        r[tap][0] = (u32x4){0u, 0u, 0u, 0u}; r[tap][1] = r[tap][0];
        if (n > 0 || tr >= 0) { const bf16_t* rp = proj + (size_t)((long)t0 + tr) * PROJW + colbase; r[tap][0] = *(const u32x4*)rp; r[tap][1] = *(const u32x4*)(rp + 8); }
    }
}
__device__ __forceinline__ void conv16(const u32x4 (&r)[4][2], const LAS float* cwm, int seg, float (&out)[16]) {
#pragma unroll
    for (int j = 0; j < 16; ++j) out[j] = 0.f;
#pragma unroll
    for (int tap = 0; tap < 4; ++tap) {
        float x0[8], x1[8]; unpack8(r[tap][0], x0); unpack8(r[tap][1], x1);
        const LAS f32x4* wp = (const LAS f32x4*)(cwm + tap * 128 + seg * 16);
        const f32x4 w0 = wp[0], w1 = wp[1], w2 = wp[2], w3 = wp[3];
#pragma unroll
        for (int j = 0; j < 4; ++j) { out[j] += w0[j] * x0[j]; out[4 + j] += w1[j] * x0[4 + j]; out[8 + j] += w2[j] * x1[j]; out[12 + j] += w3[j] * x1[4 + j]; }
    }
#pragma unroll
    for (int j = 0; j < 16; ++j) out[j] = siluf_(out[j]);
}

__device__ __forceinline__ void prep_phase(LAS unsigned char* lds, const bf16_t* __restrict__ proj, const float* __restrict__ beta, const float* __restrict__ gdec, const float* __restrict__ conv_w,
                                           bf16_t* __restrict__ NEGW, bf16_t* __restrict__ QG, bf16_t* __restrict__ KDT, bf16_t* __restrict__ AM, bf16_t* __restrict__ UT, float* __restrict__ GLAST,
                                           int n0, int ns, int first, int stride) {
    const int tid = tid_opaque(), w = __builtin_amdgcn_readfirstlane(tid >> 6), lane = tid & 63, qq = lane & 15, kq = lane >> 4;
    const int c = tid >> 3, seg = tid & 7;
    LAS float* GC = (LAS float*)(lds + GC_OFF); LAS float* BT = (LAS float*)(lds + BT_OFF); LAS float* CW = (LAS float*)(lds + CW_OFF);
    int cur_hh = -1;
    const int nv = BATCH * 8 * ns;
#define PREP_ITEM(v_) ((((v_) / (8 * ns)) * 32 + n0 + (((v_) >> 3) % ns)) * 8 + ((v_) & 7))
    u32x4 rq[4][2], rk[4][2];
#define PREP_LOAD(item_) do { const int hh_ = (item_) & 7, n_ = ((item_) >> 3) & 31, b_ = (item_) >> 8; const size_t t0_ = (size_t)b_ * SEQ + n_ * 64; const int tl_ = tid_opaque(), c_ = tl_ >> 3, sg_ = tl_ & 7; \
        conv_load(proj, t0_, c_, n_, C_DQ + hh_ * 128 + sg_ * 16, rq); conv_load(proj, t0_, c_, n_, C_DK + hh_ * 128 + sg_ * 16, rk); } while (0)
    if (first < nv) { const int it0 = PREP_ITEM(first); PREP_LOAD(it0); }
    for (int vi = first; vi < nv; vi += stride) {
        const int item = PREP_ITEM(vi);
        const int hh = item & 7, n = (item >> 3) & 31, b = item >> 8;
        const size_t t0 = (size_t)b * SEQ + n * 64;
        u32x4 rv[4][2]; { const int tl_ = tid_opaque(); conv_load(proj, t0, tl_ >> 3, n, C_DV + hh * 128 + (tl_ & 7) * 16, rv); }
        __syncthreads();
        if (hh != cur_hh) { for (int i = tid; i < 1536; i += 512) { const int mtx = i >> 9, rem = i & 511, tap = rem >> 7, ch = rem & 127; CW[i] = conv_w[tap * 3072 + mtx * 1024 + hh * 128 + ch]; } cur_hh = hh; }
        float gv = gdec[(t0 + lane) * 8 + hh];
#pragma unroll
        for (int o = 1; o < 64; o <<= 1) { const float t = __shfl_up(gv, o); if (lane >= o) gv += t; }
        const float glast = __shfl(gv, 63);
        const float gcc = __shfl(gv, (w * 8 + (lane >> 3)) & 63);
        const float bc = beta[(t0 + c) * 8 + hh];
        if (w == 0) { GC[lane] = gv; BT[lane] = beta[(t0 + lane) * 8 + hh]; }
        if (tid == 0) GLAST[item] = __expf(glast);
        __syncthreads();
        const float egc = __expf(gcc), edk = __expf(glast - gcc);
        const int cs = c ^ (seg << 3);
        {
            float qv[16]; conv16(rq, CW, seg, qv);
            float ss = 0.f;
#pragma unroll
            for (int j = 0; j < 16; ++j) ss += qv[j] * qv[j];
            ss += __shfl_xor(ss, 1); ss += __shfl_xor(ss, 2); ss += __shfl_xor(ss, 4);
            const float rq = rsqrtf(ss + 1e-6f) * 0.08838834764831845f;
#pragma unroll
            for (int j = 0; j < 16; ++j) qv[j] *= rq;
            LAS unsigned char* qp = lds + QS_OFF + c * 272 + seg * 32;
            *(LAS bf16x8*)qp = pack8(qv[0], qv[1], qv[2], qv[3], qv[4], qv[5], qv[6], qv[7]); *(LAS bf16x8*)(qp + 16) = pack8(qv[8], qv[9], qv[10], qv[11], qv[12], qv[13], qv[14], qv[15]);
            bf16_t* qg = QG + (size_t)item * 8192;
#pragma unroll
            for (int q4 = 0; q4 < 4; ++q4)
                *(u32x2*)(qg + ((((c >> 4) * 4 + (seg >> 1)) * 64 + q4 * 16 + (c & 15)) * 8 + (seg & 1) * 4)) = pack4(qv[4 * q4] * egc, qv[4 * q4 + 1] * egc, qv[4 * q4 + 2] * egc, qv[4 * q4 + 3] * egc);
        }
        {
            float kv[16]; conv16(rk, CW + 512, seg, kv);
            float ss = 0.f;
#pragma unroll
            for (int j = 0; j < 16; ++j) ss += kv[j] * kv[j];
            ss += __shfl_xor(ss, 1); ss += __shfl_xor(ss, 2); ss += __shfl_xor(ss, 4);
            const float rk = rsqrtf(ss + 1e-6f);
#pragma unroll
            for (int j = 0; j < 16; ++j) kv[j] *= rk;
            LAS unsigned char* kp = lds + KS_OFF + c * 272 + seg * 32;
            *(LAS bf16x8*)kp = pack8(kv[0], kv[1], kv[2], kv[3], kv[4], kv[5], kv[6], kv[7]); *(LAS bf16x8*)(kp + 16) = pack8(kv[8], kv[9], kv[10], kv[11], kv[12], kv[13], kv[14], kv[15]);
            const float sb = bc * egc;
#pragma unroll
            for (int j = 0; j < 16; ++j) { *(LAS bf16_t*)(lds + KBT_OFF + (seg * 16 + j) * 144 + cs * 2) = f2bf(kv[j] * sb); *(LAS bf16_t*)(lds + KDT_OFF + (seg * 16 + j) * 144 + cs * 2) = f2bf(kv[j] * edk); }
        }
        {
            float vv[16]; conv16(rv, CW + 1024, seg, vv);
#pragma unroll
            for (int j = 0; j < 16; ++j) *(LAS bf16_t*)(lds + VBT_OFF + (seg * 16 + j) * 144 + cs * 2) = f2bf(vv[j] * bc);
        }
        __syncthreads();
        {   bf16_t* kd = KDT + (size_t)item * 8192;
#pragma unroll
            for (int i = 0; i < 4; ++i) { const int piece = tid + 512 * i, dk = piece >> 4, pp = piece & 15;
                const u32x2 v = *(const LAS u32x2*)(lds + KDT_OFF + dk * 144 + (((pp >> 1) ^ (dk >> 4)) * 16) + (pp & 1) * 8);
                *(u32x2*)(kd + ((((dk >> 4) * 2 + (pp >> 3)) * 64 + (pp & 3) * 16 + (dk & 15)) * 8 + ((pp >> 2) & 1) * 4)) = v; }
        }
#pragma unroll
        for (int tsel = 0; tsel < 2; ++tsel) {
            const int ti = 2 * w + tsel, ta = ti >> 2, tb = ti & 3;
            f32x4 akk = (f32x4){0.f, 0.f, 0.f, 0.f}, aqk = akk;
#pragma unroll
            for (int s4 = 0; s4 < 4; ++s4) {
                const bf16x8 A = *(const LAS bf16x8*)(lds + KS_OFF + (16 * ta + qq) * 272 + s4 * 64 + kq * 16);
                const bf16x8 Bk = *(const LAS bf16x8*)(lds + KS_OFF + (16 * tb + qq) * 272 + s4 * 64 + kq * 16);
                const bf16x8 Bq = *(const LAS bf16x8*)(lds + QS_OFF + (16 * tb + qq) * 272 + s4 * 64 + kq * 16);
                akk = MFMA16(A, Bk, akk); aqk = MFMA16(A, Bq, aqk);
            }
            const int y = 16 * tb + qq, x0 = 16 * ta + 4 * kq;
            const float gcy = GC[y], by = BT[y];
            float v1[4], v2[4], xv[4], av[4];
#pragma unroll
            for (int r = 0; r < 4; ++r) { const int x = x0 + r; const float gcx = GC[x], bx = BT[x];
                const float e_yx = (y >= x) ? __expf(gcy - gcx) : 0.f;
                const float e_xy = (x > y) ? __expf(gcx - gcy) : 0.f;
                v1[r] = (y > x) ? by * akk[r] * e_yx : 0.f;
                v2[r] = bx * akk[r] * e_xy;
                xv[r] = ((y == x) ? 1.f : 0.f) - v1[r];
                av[r] = aqk[r] * e_yx; }
            *(LAS u32x2*)(lds + PB_OFF + y * 144 + x0 * 2) = pack4(v1[0], v1[1], v1[2], v1[3]);
            *(LAS u32x2*)(lds + PB_OFF + 9216 + y * 144 + x0 * 2) = pack4(v2[0], v2[1], v2[2], v2[3]);
            *(LAS u32x2*)(lds + PB_OFF + 18432 + y * 144 + x0 * 2) = pack4(xv[0], xv[1], xv[2], xv[3]);
            *(u32x2*)(AM + (size_t)item * 4096 + (((tb * 2 + (ta >> 1)) * 64 + lane) * 8 + (ta & 1) * 4)) = pack4(av[0], av[1], av[2], av[3]);
        }
        __syncthreads();
        if (vi + stride < nv) { const int itn = PREP_ITEM(vi + stride); PREP_LOAD(itn); }
#pragma unroll 1
        for (int ph = 0; ph <= 5; ++ph) {
            const int bc_ = PB_OFF + (ph & 1) * PBUF, bn_ = PB_OFF + ((ph + 1) & 1) * PBUF;
            const int pa_cur = bc_, pt_cur = bc_ + 9216, x_new = bc_ + 18432, pa_new = bn_, pt_new = bn_ + 9216, x_prev = bn_ + 18432;
#pragma unroll
            for (int tsel = 0; tsel < 2; ++tsel) {
                const int ti = 2 * w + tsel, ta = ti >> 2, tb = ti & 3;
                const int ra = (16 * ta + qq) * 144 + kq * 16, rb = (16 * tb + qq) * 144 + kq * 16, wo = (16 * tb + qq) * 144 + (16 * ta + 4 * kq) * 2;
                const bf16x8 PAa0 = *(const LAS bf16x8*)(lds + pa_cur + ra), PAa1 = *(const LAS bf16x8*)(lds + pa_cur + ra + 64);
                const bf16x8 PTa0 = *(const LAS bf16x8*)(lds + pt_cur + ra), PTa1 = *(const LAS bf16x8*)(lds + pt_cur + ra + 64);
                if (ph < 5) {
                    const bf16x8 PAb0 = *(const LAS bf16x8*)(lds + pa_cur + rb), PAb1 = *(const LAS bf16x8*)(lds + pa_cur + rb + 64);
                    const bf16x8 PTb0 = *(const LAS bf16x8*)(lds + pt_cur + rb), PTb1 = *(const LAS bf16x8*)(lds + pt_cur + rb + 64);
                    f32x4 d1 = MFMA16(PAa0, PTb0, ((f32x4){0.f, 0.f, 0.f, 0.f})); d1 = MFMA16(PAa1, PTb1, d1);
                    f32x4 d2 = MFMA16(PTa0, PAb0, ((f32x4){0.f, 0.f, 0.f, 0.f})); d2 = MFMA16(PTa1, PAb1, d2);
                    *(LAS u32x2*)(lds + pt_new + wo) = pack4(d1[0], d1[1], d1[2], d1[3]);
                    *(LAS u32x2*)(lds + pa_new + wo) = pack4(d2[0], d2[1], d2[2], d2[3]);
                }
                if (ph >= 1) {
                    const bf16x8 Xb0 = *(const LAS bf16x8*)(lds + x_prev + rb), Xb1 = *(const LAS bf16x8*)(lds + x_prev + rb + 64);
                    const u32x2 xc = *(const LAS u32x2*)(lds + x_prev + wo);
                    f32x4 d3 = (f32x4){__uint_as_float(xc.x << 16), __uint_as_float(xc.x & 0xffff0000u), __uint_as_float(xc.y << 16), __uint_as_float(xc.y & 0xffff0000u)};
                    d3 = MFMA16(PTa0, Xb0, d3); d3 = MFMA16(PTa1, Xb1, d3);
                    *(LAS u32x2*)(lds + x_new + wo) = pack4(d3[0], d3[1], d3[2], d3[3]);
                }
            }
            __syncthreads();
        }
        {   const int x5 = PB_OFF + PBUF + 18432;
#pragma unroll
            for (int tt = 0; tt < 4; ++tt) {
                const int tu = 4 * w + tt;
                {   const int ta = tu & 3, tb = tu >> 2;
                    f32x4 d = (f32x4){0.f, 0.f, 0.f, 0.f};
#pragma unroll
                    for (int s2 = 0; s2 < 2; ++s2) d = MFMA16(*(const LAS bf16x8*)(lds + x5 + (16 * ta + qq) * 144 + s2 * 64 + kq * 16), *(const LAS bf16x8*)(lds + VBT_OFF + (16 * tb + qq) * 144 + (((4 * s2 + kq) ^ tb) * 16)), d);
                    *(u32x2*)(UT + (size_t)item * 8192 + ((tb * 4 + ta) * 64 + lane) * 4) = pack4(d[0], d[1], d[2], d[3]); }
                {   const int ta = tu >> 2, tb = tu & 3;
                    f32x4 d = (f32x4){0.f, 0.f, 0.f, 0.f};
#pragma unroll
                    for (int s2 = 0; s2 < 2; ++s2) d = MFMA16(*(const LAS bf16x8*)(lds + KBT_OFF + (16 * ta + qq) * 144 + (((4 * s2 + kq) ^ ta) * 16)), *(const LAS bf16x8*)(lds + x5 + (16 * tb + qq) * 144 + s2 * 64 + kq * 16), d);
                    *(u32x2*)(NEGW + (size_t)item * 8192 + (((tb * 4 + (ta >> 1)) * 64 + lane) * 8 + (ta & 1) * 4)) = pack4(-d[0], -d[1], -d[2], -d[3]); }
            }
        }
    }
#undef PREP_LOAD
#undef PREP_ITEM
}

template <class GridBar>
__device__ __forceinline__ void scan_phase(LAS unsigned char* lds, const bf16_t* __restrict__ NEGW, const bf16_t* __restrict__ QG, const bf16_t* __restrict__ KDT, const bf16_t* __restrict__ AM,
                                           const bf16_t* __restrict__ UT, const float* __restrict__ GLAST, const bf16_t* __restrict__ proj, const float* __restrict__ dn_norm_w, bf16_t* __restrict__ mixed, int bh,
                                           int nsplit, const GridBar& gridbar) {
    const int tid = tid_opaque(), w = __builtin_amdgcn_readfirstlane(tid >> 6), lane = tid & 63, qq = lane & 15, kq = lane >> 4;
    const int b = bh >> 3, hh = bh & 7, c = tid >> 3, seg = tid & 7;
    f32x4 S[8];
#pragma unroll
    for (int i = 0; i < 8; ++i) S[i] = (f32x4){0.f, 0.f, 0.f, 0.f};
#define GDN_STAGE(nn, bufoff) do { const size_t it_ = (size_t)((b * 32 + (nn)) * 8 + hh); \
        _Pragma("unroll") for (int i_ = 0; i_ < 7; ++i_) { const bf16_t* src_ = (i_ < 2) ? NEGW + it_ * 8192 + (i_ * 512 + tid) * 8 : (i_ < 4) ? QG + it_ * 8192 + ((i_ - 2) * 512 + tid) * 8 \
            : (i_ < 6) ? KDT + it_ * 8192 + ((i_ - 4) * 512 + tid) * 8 : AM + it_ * 4096 + tid * 8; \
            __builtin_amdgcn_global_load_lds((const unsigned*)src_, (LAS unsigned*)(lds + (bufoff) + i_ * 8192 + w * 1024), 16, 0, 0); } } while (0)
    if (tid < 128) *(LAS float*)(lds + SC_NW_OFF + tid * 4) = dn_norm_w[tid];
    GDN_STAGE(0, 0);
    u32x2 uu_n[4]; float gl_n; u32x4 z0_n, z1_n;
#define GDN_LOADS(nn) do { const size_t it_ = (size_t)((b * 32 + (nn)) * 8 + hh), t0_ = (size_t)b * SEQ + (nn) * 64; \
        const bf16_t* up_ = UT + it_ * 8192 + (w * 4 * 64 + lane) * 4; const float* gp_ = GLAST + it_; const bf16_t* zp_ = proj + (t0_ + c) * PROJW + C_DZ + hh * 128 + seg * 16; \
        asm volatile("global_load_dwordx2 %0, %7, off\n\tglobal_load_dwordx2 %1, %7, off offset:512\n\tglobal_load_dwordx2 %2, %7, off offset:1024\n\tglobal_load_dwordx2 %3, %7, off offset:1536\n\t" \
                     "global_load_dword %4, %8, off\n\tglobal_load_dwordx4 %5, %9, off\n\tglobal_load_dwordx4 %6, %9, off offset:16" \
                     : "=&v"(uu_n[0]), "=&v"(uu_n[1]), "=&v"(uu_n[2]), "=&v"(uu_n[3]), "=&v"(gl_n), "=&v"(z0_n), "=&v"(z1_n) : "v"(up_), "v"(gp_), "v"(zp_) : "memory"); } while (0)
#define GDN_LOADS_WAIT() asm volatile("s_waitcnt vmcnt(0)" : "+v"(uu_n[0]), "+v"(uu_n[1]), "+v"(uu_n[2]), "+v"(uu_n[3]), "+v"(gl_n), "+v"(z0_n), "+v"(z1_n) :: "memory")
    GDN_LOADS(0);
    GDN_LOADS_WAIT();
    __syncthreads();
#pragma unroll 1
    for (int n = 0; n < 32; ++n) {
        const int buf = (n & 1) * SC_BUF;
        const size_t t0 = (size_t)b * SEQ + n * 64;
        f32x4 vn[4];
#pragma unroll
        for (int mt = 0; mt < 4; ++mt) vn[mt] = (f32x4){__uint_as_float(uu_n[mt].x << 16), __uint_as_float(uu_n[mt].x & 0xffff0000u), __uint_as_float(uu_n[mt].y << 16), __uint_as_float(uu_n[mt].y & 0xffff0000u)};
        const float gl = gl_n; const u32x4 z0 = z0_n, z1 = z1_n;
        if (n + 1 == nsplit) gridbar();
        if (n + 1 < 32) { GDN_STAGE(n + 1, SC_BUF - buf); GDN_LOADS(n + 1); }
        bf16x8 Sb[4];
#pragma unroll
        for (int s4 = 0; s4 < 4; ++s4) Sb[s4] = pack8(S[2 * s4][0], S[2 * s4][1], S[2 * s4][2], S[2 * s4][3], S[2 * s4 + 1][0], S[2 * s4 + 1][1], S[2 * s4 + 1][2], S[2 * s4 + 1][3]);
        f32x4 o[4];
        bf16x8 F1[16], F2[16];
#pragma unroll
        for (int i = 0; i < 16; ++i) F1[i] = *(const LAS bf16x8*)(lds + buf + (i * 64 + lane) * 16);
#pragma unroll
        for (int i = 0; i < 16; ++i) F2[i] = *(const LAS bf16x8*)(lds + buf + 16384 + (i * 64 + lane) * 16);
        __builtin_amdgcn_sched_barrier(0);
#pragma unroll
        for (int s4 = 0; s4 < 4; ++s4)
#pragma unroll
            for (int mt = 0; mt < 4; ++mt) vn[mt] = MFMA16(F1[mt * 4 + s4], Sb[s4], vn[mt]);
#pragma unroll
        for (int mt = 0; mt < 4; ++mt) o[mt] = (f32x4){0.f, 0.f, 0.f, 0.f};
#pragma unroll
        for (int s4 = 0; s4 < 4; ++s4)
#pragma unroll
            for (int mt = 0; mt < 4; ++mt) o[mt] = MFMA16(F2[mt * 4 + s4], Sb[s4], o[mt]);
        __builtin_amdgcn_sched_barrier(0);
        bf16x8 F3[8];
#pragma unroll
        for (int i = 0; i < 8; ++i) F3[i] = *(const LAS bf16x8*)(lds + buf + 49152 + (i * 64 + lane) * 16);
#pragma unroll
        for (int i = 0; i < 16; ++i) F1[i] = *(const LAS bf16x8*)(lds + buf + 32768 + (i * 64 + lane) * 16);
        bf16x8 Vb[2];
#pragma unroll
        for (int s2 = 0; s2 < 2; ++s2) Vb[s2] = pack8(vn[2 * s2][0], vn[2 * s2][1], vn[2 * s2][2], vn[2 * s2][3], vn[2 * s2 + 1][0], vn[2 * s2 + 1][1], vn[2 * s2 + 1][2], vn[2 * s2 + 1][3]);
#pragma unroll
        for (int s2 = 0; s2 < 2; ++s2)
#pragma unroll
            for (int mt = 0; mt < 4; ++mt) o[mt] = MFMA16(F3[mt * 2 + s2], Vb[s2], o[mt]);
        __builtin_amdgcn_sched_barrier(0);
#pragma unroll
        for (int mt = 0; mt < 8; ++mt) S[mt] = S[mt] * gl;
#pragma unroll
        for (int s2 = 0; s2 < 2; ++s2)
#pragma unroll
            for (int mt = 0; mt < 8; ++mt) S[mt] = MFMA16(F1[mt * 2 + s2], Vb[s2], S[mt]);
#pragma unroll
        for (int mt = 0; mt < 4; ++mt)
#pragma unroll
            for (int r = 0; r < 4; ++r) *(LAS float*)(lds + SC_OT_OFF + (16 * mt + 4 * kq + r) * SC_OT_STRIDE + (16 * w + qq) * 4) = o[mt][r];
        asm volatile("s_waitcnt lgkmcnt(0)" ::: "memory"); __builtin_amdgcn_s_barrier(); asm volatile("" ::: "memory");
        {   const LAS f32x4* op = (const LAS f32x4*)(lds + SC_OT_OFF + c * SC_OT_STRIDE + seg * 64);
            const f32x4 o0 = op[0], o1 = op[1], o2 = op[2], o3 = op[3];
            float ov[16] = {o0[0], o0[1], o0[2], o0[3], o1[0], o1[1], o1[2], o1[3], o2[0], o2[1], o2[2], o2[3], o3[0], o3[1], o3[2], o3[3]};
            float ss = 0.f;
#pragma unroll
            for (int j = 0; j < 16; ++j) ss += ov[j] * ov[j];
            ss += __shfl_xor(ss, 1); ss += __shfl_xor(ss, 2); ss += __shfl_xor(ss, 4);
            const float r = rsqrtf(ss * (1.0f / 128.0f) + 1e-6f);
            float zf0[8], zf1[8]; unpack8(z0, zf0); unpack8(z1, zf1);
            float nw[16];
#pragma unroll
            for (int j = 0; j < 4; ++j) { const f32x4 t4 = *(const LAS f32x4*)(lds + SC_NW_OFF + (seg * 16 + 4 * j) * 4); nw[4 * j] = t4[0]; nw[4 * j + 1] = t4[1]; nw[4 * j + 2] = t4[2]; nw[4 * j + 3] = t4[3]; }
#pragma unroll
            for (int j = 0; j < 8; ++j) { ov[j] = ov[j] * r * nw[j] * siluf_(zf0[j]); ov[8 + j] = ov[8 + j] * r * nw[8 + j] * siluf_(zf1[j]); }
            bf16_t* mp = mixed + (t0 + c) * D + 1024 + hh * 128 + seg * 16;
            *(bf16x8*)mp = pack8(ov[0], ov[1], ov[2], ov[3], ov[4], ov[5], ov[6], ov[7]); *(bf16x8*)(mp + 8) = pack8(ov[8], ov[9], ov[10], ov[11], ov[12], ov[13], ov[14], ov[15]);
        }
        GDN_LOADS_WAIT();
        __syncthreads();
    }
#undef GDN_LOADS_WAIT
#undef GDN_STAGE
#undef GDN_LOADS
}
}

#define XB_TMO      128
#define XB_XCNT(j)  (256  + 64 * (j))
#define XB_XSUB(j)  (1280 + 64 * (j))
#define XB_XGEN(j)  (2304 + 64 * (j))
#define XB_TOP      3328
#define XB_TOPGEN   3392
#define XCD_BAR_WORDS 3456
#define XB_SPIN_CAP (1u << 18)
__device__ __forceinline__ unsigned xb_ld(unsigned* p)              { return __hip_atomic_load(p, __ATOMIC_RELAXED, __HIP_MEMORY_SCOPE_AGENT); }
__device__ __forceinline__ unsigned xb_add(unsigned* p, unsigned v) { return __hip_atomic_fetch_add(p, v, __ATOMIC_RELAXED, __HIP_MEMORY_SCOPE_AGENT); }
__device__ __forceinline__ unsigned xb_xcc_id() { return (unsigned)__builtin_amdgcn_s_getreg((3 << 11) | 20) & 0xFu; }
#define XB_SPIN(cond, bar) do { unsigned _sp = 0; while (cond) { __builtin_amdgcn_s_sleep(1); \
    if ((++_sp & 255u) == 0u) { if (xb_ld(&(bar)[XB_TMO])) break; if (_sp > XB_SPIN_CAP) { atomicAdd(&(bar)[XB_TMO], 1u); break; } } } } while (0)
struct XcdBarrier { unsigned* bar; unsigned x; volatile LAS unsigned* st; };
__device__ __forceinline__ XcdBarrier xcd_barrier_post(unsigned* bar, volatile LAS unsigned* st) {
    XcdBarrier b; b.bar = bar; b.x = xb_xcc_id(); b.st = st;
    if (threadIdx.x == 0) (void)xb_add(&bar[XB_XCNT(b.x)], 1u);
    return b;
}
__device__ __forceinline__ void xcd_barrier_complete(unsigned* bar, unsigned x, unsigned& nloc, unsigned& nx) {
    const unsigned G = gridDim.x * gridDim.y * gridDim.z;
    unsigned sum, cnt, mine, sp = 0u;
    for (;;) {
        sum = 0u; cnt = 0u; mine = 0u;
#pragma unroll
        for (unsigned j = 0; j < 16; ++j) { const unsigned c = xb_ld(&bar[XB_XCNT(j)]); sum += c; cnt += (c > 0u) ? 1u : 0u; mine = (j == x) ? c : mine; }
        if (sum == G) break;
        __builtin_amdgcn_s_sleep(1);
        if ((++sp & 255u) == 0u) { if (xb_ld(&bar[XB_TMO])) break; if (sp > XB_SPIN_CAP) { atomicAdd(&bar[XB_TMO], 1u); break; } }
    }
    nloc = mine > 0u ? mine : 1u; nx = cnt > 0u ? cnt : 1u;
}
__device__ __forceinline__ void xcd_barrier(const XcdBarrier& b) {
    asm volatile("s_waitcnt vmcnt(0)" ::: "memory");
    __syncthreads();
    if (threadIdx.x == 0) {
        unsigned* bar = b.bar;
        unsigned bx = b.x; asm volatile("" : "+s"(bx));
        __builtin_amdgcn_s_waitcnt(0);
        unsigned nloc = b.st[0], nx = b.st[1];
        if (nloc == 0u) { xcd_barrier_complete(bar, bx, nloc, nx); b.st[0] = nloc; b.st[1] = nx; }
        const unsigned old = xb_add(&bar[XB_XSUB(bx)], 1u);
        const unsigned gen = old / nloc;
        if (old + 1u == (gen + 1u) * nloc) {
            __builtin_amdgcn_fence(__ATOMIC_RELEASE, "agent");
            asm volatile("s_waitcnt vmcnt(0)" ::: "memory");
            const unsigned og = xb_add(&bar[XB_TOP], 1u);
            const unsigned tg = og / nx;
            if (og + 1u == (tg + 1u) * nx) xb_add(&bar[XB_TOPGEN], 1u);
            else XB_SPIN(xb_ld(&bar[XB_TOPGEN]) == tg, bar);
            __builtin_amdgcn_fence(__ATOMIC_ACQUIRE, "agent");
            xb_add(&bar[XB_XGEN(bx)], 1u);
            asm volatile("s_waitcnt vmcnt(0)" ::: "memory");
        } else {
            XB_SPIN(xb_ld(&bar[XB_XGEN(bx)]) == gen, bar);
            __builtin_amdgcn_fence(__ATOMIC_ACQUIRE, "agent");
            asm volatile("s_waitcnt vmcnt(0)" ::: "memory");
        }
    }
    __syncthreads();
}

constexpr int NWAVES = 8;
constexpr int PHASE_LDS = gdn::SCAN_LDS;
constexpr int XB_OFF = PHASE_LDS, LDS_BYTES = PHASE_LDS + 256;
static_assert(gdn::PREP_LDS <= PHASE_LDS && pg8::STAGE_BYTES <= PHASE_LDS && att::LDS_BYTES <= PHASE_LDS && LDS_BYTES <= 163840, "LDS map");

template <int MODE>
__device__ __forceinline__ void wT_tile(LAS float* t, const float* __restrict__ W, bf16_t* __restrict__ WT, int K, int N, int Npad, int tile, int ht, bool active) {
    const int ntn = Npad / 64, ntk = K / 64, per = ntn * ntk;
    const int bz = tile / per, rem = tile % per, n0 = (rem % ntn) * 64, k0 = (rem / ntn) * 64;
    const float* src = W + (size_t)bz * K * N; bf16_t* dst = WT + (size_t)bz * Npad * K;
    if (active) {
#pragma unroll
        for (int p = 0; p < 4; ++p) { const int kk = p * 16 + (ht >> 4), nn = (ht & 15) * 4;
            f32x4 v = (f32x4){0.f, 0.f, 0.f, 0.f};
            if (n0 + nn + 3 < N) v = *(const f32x4*)(src + (size_t)(k0 + kk) * N + n0 + nn);
            t[kk * 65 + nn] = v[0]; t[kk * 65 + nn + 1] = v[1]; t[kk * 65 + nn + 2] = v[2]; t[kk * 65 + nn + 3] = v[3]; }
    }
    __syncthreads();
    if (active) {
        const int n = ht >> 2, ks = (ht & 3) * 16; const int c = n0 + n;
        int drow = c;
        if (MODE == 1) drow = ((c % 2048) / 128) * 256 + (c / 2048) * 128 + (c % 128);
        u32x4 w0, w1;
#define TT(i) t[(ks + (i)) * 65 + n]
        w0.x = pk2(TT(0), TT(1)); w0.y = pk2(TT(2), TT(3)); w0.z = pk2(TT(4), TT(5)); w0.w = pk2(TT(6), TT(7));
        w1.x = pk2(TT(8), TT(9)); w1.y = pk2(TT(10), TT(11)); w1.z = pk2(TT(12), TT(13)); w1.w = pk2(TT(14), TT(15));
#undef TT
        bf16_t* o = dst + (size_t)drow * K + k0 + ks;
        *(u32x4*)o = w0; *(u32x4*)(o + 8) = w1;
    }
    __syncthreads();
}
template <int MODE>
__device__ __forceinline__ void wT_phase(LAS unsigned char* lds, const float* W, bf16_t* WT, int K, int N, int Npad, int batch, int wg, int G) {
    const int tid = tid_opaque(), half = tid >> 8, ht = tid & 255;
    LAS float* t = (LAS float*)(lds + half * 16640);
    const int ntiles = batch * (Npad / 64) * (K / 64);
    for (int base = wg * 2; base < ntiles; base += G * 2) { const int tile = base + half; wT_tile<MODE>(t, W, WT, K, N, Npad, tile < ntiles ? tile : 0, ht, tile < ntiles); }
}
template <int MODE>
__device__ __forceinline__ void wT8_phase(LAS unsigned char* lds, const float* __restrict__ W, unsigned char* __restrict__ WT, int K, int N, int batch, unsigned* ctr, int t0 = 0, int t1 = -1) {
    const int tid = tid_opaque(), nn4 = tid & 15, kq = tid >> 4;
    const int ntn = N / 64, ntk = K / 256, per = ntn * ntk, ntiles = (t1 < 0 ? batch * per : t1) - t0;
    LAS int* q = (LAS int*)(lds + 32768);
    f32x4 v[8], vn[8];
#define WT8_LOAD(dst, tile_) do { const int bz_ = ((tile_) + t0) / per, rem_ = ((tile_) + t0) % per, n0_ = (rem_ % ntn) * 64, k0_ = (rem_ / ntn) * 256; \
        const float* src_ = W + (size_t)bz_ * K * N + (size_t)(k0_ + kq * 8) * N + n0_ + nn4 * 4; \
        _Pragma("unroll") for (int r = 0; r < 8; ++r) dst[r] = __builtin_nontemporal_load((const f32x4*)(src_ + (size_t)r * N)); } while (0)
    __syncthreads();
    if (tid == 0) { const int r0 = (int)atomicAdd(ctr, 2u); q[0] = r0; q[1] = r0 + 1; }
    __syncthreads();
    int sup = q[0], supn = q[1], sub = 0;
    __syncthreads();
    int tile = 2 * sup;
    if (tile < ntiles) WT8_LOAD(vn, tile);
    while (tile < ntiles) {
        const int bz = (tile + t0) / per, rem = (tile + t0) % per, n0 = (rem % ntn) * 64, k0 = (rem / ntn) * 256;
        const int nxt = sub ? ((supn < 0x3fffffff) ? 2 * supn : 0x7fffffff) : tile + 1;
        int fut = 0x7fffffff;
        if (sub) { if (tid == 0 && nxt < ntiles) fut = (int)atomicAdd(ctr, 1u); }
#pragma unroll
        for (int r = 0; r < 8; ++r) v[r] = vn[r];
        if (nxt < ntiles) WT8_LOAD(vn, nxt);
        __syncthreads();
#pragma unroll
        for (int g = 0; g < 2; ++g)
#pragma unroll
            for (int j = 0; j < 4; ++j)
                *(LAS unsigned*)(lds + (nn4 * 4 + j) * 272 + kq * 8 + g * 4) = pk4_fp8(v[4 * g][j] * W_SCALE, v[4 * g + 1][j] * W_SCALE, v[4 * g + 2][j] * W_SCALE, v[4 * g + 3][j] * W_SCALE);
        if (sub && tid == 0) q[0] = fut;
        __syncthreads();
        unsigned char* dst = WT + (size_t)bz * N * K;
#pragma unroll
        for (int i = 0; i < 2; ++i) { const int pc = tid + 512 * i, row = pc >> 4, sg = pc & 15; const int c = n0 + row;
            int drow = c;
            if (MODE == 1) drow = ((c % 2048) / 128) * 256 + (c / 2048) * 128 + (c % 128);
            __builtin_nontemporal_store(*(const LAS u32x4*)(lds + row * 272 + sg * 16), (u32x4*)(dst + (size_t)drow * K + k0 + sg * 16)); }
        if (sub) { sup = supn; supn = q[0]; }
        sub ^= 1; tile = nxt;
    }
#undef WT8_LOAD
    __syncthreads();
}
__device__ __forceinline__ void rms_phase(const float* x, const float* w, bf16_t* o, float eps, int wg, int G) {
    const int tid = tid_opaque(), wave = tid >> 6, lane = tid & 63;
    for (int row = wg * NWAVES + wave; row < T; row += G * NWAVES) {
        const f32x4* xr = (const f32x4*)(x + (size_t)row * D) + lane; const f32x4* wr = (const f32x4*)w + lane;
        f32x4 v[8]; float s = 0.f;
#pragma unroll
        for (int j = 0; j < 8; ++j) { v[j] = xr[64 * j]; s += (v[j][0] * v[j][0] + v[j][1] * v[j][1]) + (v[j][2] * v[j][2] + v[j][3] * v[j][3]); }
        const float r = rsqrtf(wave_sum(s) * (1.0f / D) + eps);
        u32x2* o8 = (u32x2*)(o + (size_t)row * D) + lane;
#pragma unroll
        for (int j = 0; j < 8; ++j) { const f32x4 g = wr[64 * j]; u32x2 q; q.x = pk2(v[j][0] * r * g[0], v[j][1] * r * g[1]); q.y = pk2(v[j][2] * r * g[2], v[j][3] * r * g[3]); o8[64 * j] = q; }
    }
}
__device__ __forceinline__ unsigned pk4_i8(float a, float b, float c, float d) {
    const int ia = (int)rintf(a), ib = (int)rintf(b), ic = (int)rintf(c), id = (int)rintf(d);
    return ((unsigned)ia & 255u) | (((unsigned)ib & 255u) << 8) | (((unsigned)ic & 255u) << 16) | ((unsigned)id << 24); }
__device__ __forceinline__ void rms8_phase(const float* x, const float* w, unsigned char* o, float* xs, float eps, int wg, int G) {
    const int tid = tid_opaque(), wave = tid >> 6, lane = tid & 63;
    for (int row = wg * NWAVES + wave; row < T; row += G * NWAVES) {
        const f32x4* xr = (const f32x4*)(x + (size_t)row * D) + lane; const f32x4* wr = (const f32x4*)w + lane;
        f32x4 v[8]; float s = 0.f;
#pragma unroll
        for (int j = 0; j < 8; ++j) { v[j] = xr[64 * j]; s += (v[j][0] * v[j][0] + v[j][1] * v[j][1]) + (v[j][2] * v[j][2] + v[j][3] * v[j][3]); }
        const float r = rsqrtf(wave_sum(s) * (1.0f / D) + eps);
        float am = 0.f;
#pragma unroll
        for (int j = 0; j < 8; ++j) { const f32x4 g = wr[64 * j]; v[j][0] *= r * g[0]; v[j][1] *= r * g[1]; v[j][2] *= r * g[2]; v[j][3] *= r * g[3];
            am = fmaxf(am, fmaxf(fmaxf(fabsf(v[j][0]), fabsf(v[j][1])), fmaxf(fabsf(v[j][2]), fabsf(v[j][3])))); }
#pragma unroll
        for (int o2 = 1; o2 < 64; o2 <<= 1) am = fmaxf(am, __shfl_xor(am, o2));
        am = fmaxf(am, 1e-20f);
        const float qs = 127.0f / am;
        unsigned* o4 = (unsigned*)(o + (size_t)row * D) + lane;
#pragma unroll
        for (int j = 0; j < 8; ++j) o4[64 * j] = pk4_i8(v[j][0] * qs, v[j][1] * qs, v[j][2] * qs, v[j][3] * qs);
        if (lane == 0) xs[row] = am * (1.0f / 127.0f);
    }
}
__device__ __forceinline__ void win8_phase(LAS unsigned char* lds, const float* __restrict__ W, unsigned char* __restrict__ WT, float* __restrict__ wsc, int K, int N, int Npad, int wg, int G) {
    const int tid = tid_opaque(), nn4 = tid & 15, kq = tid >> 4;
    LAS float* pm = (LAS float*)(lds + 32768); LAS float* qsv = (LAS float*)(lds + 32768 + 8192);
    for (int task = wg; task < Npad / 64; task += G) {
        const int n0 = task * 64; const bool inb = (n0 + nn4 * 4 + 3 < N);
        f32x4 m4 = (f32x4){0.f, 0.f, 0.f, 0.f};
        const float* src = W + (size_t)(kq * 64) * N + n0 + nn4 * 4;
#pragma unroll 8
        for (int r = 0; r < 64; ++r) { f32x4 v = (f32x4){0.f, 0.f, 0.f, 0.f}; if (inb) v = *(const f32x4*)(src + (size_t)r * N);
            m4[0] = fmaxf(m4[0], fabsf(v[0])); m4[1] = fmaxf(m4[1], fabsf(v[1])); m4[2] = fmaxf(m4[2], fabsf(v[2])); m4[3] = fmaxf(m4[3], fabsf(v[3])); }
        __syncthreads();
        *(LAS f32x4*)(pm + kq * 64 + nn4 * 4) = m4;
        __syncthreads();
        if (tid < 64) { float cm = 0.f;
#pragma unroll
            for (int q = 0; q < 32; ++q) cm = fmaxf(cm, pm[q * 64 + tid]);
            qsv[tid] = cm > 0.f ? 127.0f / cm : 0.f; wsc[n0 + tid] = cm * (1.0f / 127.0f); }
        __syncthreads();
        const f32x4 qs = *(const LAS f32x4*)(qsv + nn4 * 4);
#pragma unroll 1
        for (int kb = 0; kb < K / 256; ++kb) {
            f32x4 v[8];
            const float* s2 = W + (size_t)(kb * 256 + kq * 8) * N + n0 + nn4 * 4;
#pragma unroll
            for (int r = 0; r < 8; ++r) { v[r] = (f32x4){0.f, 0.f, 0.f, 0.f}; if (inb) v[r] = *(const f32x4*)(s2 + (size_t)r * N); }
#pragma unroll
            for (int g = 0; g < 2; ++g)
#pragma unroll
                for (int j = 0; j < 4; ++j)
                    *(LAS unsigned*)(lds + (nn4 * 4 + j) * 272 + kq * 8 + g * 4) = pk4_i8(v[4 * g][j] * qs[j], v[4 * g + 1][j] * qs[j], v[4 * g + 2][j] * qs[j], v[4 * g + 3][j] * qs[j]);
            __syncthreads();
#pragma unroll
            for (int i = 0; i < 2; ++i) { const int pc = tid + 512 * i, row = pc >> 4, sg = pc & 15;
                *(u32x4*)(WT + (size_t)(n0 + row) * K + kb * 256 + sg * 16) = *(const LAS u32x4*)(lds + row * 272 + sg * 16); }
            __syncthreads();
        }
    }
}
__device__ __forceinline__ void wb_phase(const float* nw, const float* wr, float* WB, int wg, int G) {
    const int tid = tid_opaque();
    for (int o = wg * 512 + tid; o < D * NE; o += G * 512) { const int i = o & 3, e = (o >> 2) & 31, kq = (o >> 7) & 3, jj = o >> 9, k = 16 * jj + 4 * kq + i; WB[o] = nw[k] * wr[k * NE + e]; }
}
__device__ __forceinline__ void router_phase(LAS unsigned char* lds, const bf16_t* h, const float* nw, const float* WB, const float* br, unsigned char* u, float* rstd, int* topi, float* gate, int* lrank, int* cnt, int wg, int G, bool count) {
    const int tid = tid_opaque(), wave = __builtin_amdgcn_readfirstlane(tid >> 6), lane = tid & 63, qq = lane & 15, kq = lane >> 4;
    LAS int* lh = (LAS int*)(lds + 65536);
    if (tid < 32) lh[tid] = 0;
    if (wg == 0) ((unsigned*)(u + (size_t)T * D))[tid] = 0u;
#define RT_STAGE(ch_) do { _Pragma("unroll") for (int i_ = 0; i_ < 4; ++i_) \
        __builtin_amdgcn_global_load_lds((const unsigned*)(WB + (size_t)(ch_) * 8192 + (i_ * 512 + tid) * 4), (LAS unsigned*)(lds + ((ch_) & 1) * 32768 + i_ * 8192 + wave * 1024), 16, 0, 0); } while (0)
    RT_STAGE(0);
    for (int i = tid; i < D; i += 512) *(LAS float*)(lds + 65536 + 256 + i * 4) = nw[i];
    const int task = wg * 4 + (wave & 3);
    const int tok = task * 16 + qq;
    const bf16_t* hp = h + (size_t)tok * D + 4 * kq;
    unsigned* up = (unsigned*)(u + (size_t)tok * D + 4 * kq);
    f32x4 acc0 = (f32x4){0.f, 0.f, 0.f, 0.f}, acc1 = acc0; float ssq = 0.f;
    u32x2 hA[16], hB[16];
#define RT_HLOAD(dst, ch_) do { _Pragma("unroll") for (int j2 = 0; j2 < 16; ++j2) dst[j2] = *(const u32x2*)(hp + 16 * ((ch_) * 16 + j2)); } while (0)
#define RT_COMPUTE(src, ch_) do { const LAS unsigned char* bp = lds + ((ch_) & 1) * 32768 + (kq * 32 + qq) * 16; const LAS unsigned char* gp = lds + 65536 + 256 + ((ch_) * 256 + 4 * kq) * 4; \
        _Pragma("unroll") for (int j2 = 0; j2 < 16; ++j2) { const int jj = (ch_) * 16 + j2; const f32x4 hv = (f32x4){__uint_as_float(src[j2].x << 16), __uint_as_float(src[j2].x & 0xffff0000u), __uint_as_float(src[j2].y << 16), __uint_as_float(src[j2].y & 0xffff0000u)}, g = *(const LAS f32x4*)(gp + j2 * 64); \
            const f32x4 b0 = *(const LAS f32x4*)(bp + j2 * 2048), b1 = *(const LAS f32x4*)(bp + j2 * 2048 + 256); \
            ssq += (hv[0] * hv[0] + hv[1] * hv[1]) + (hv[2] * hv[2] + hv[3] * hv[3]); \
            up[4 * jj] = pk4_fp8(hv[0] * g[0] * U_SCALE, hv[1] * g[1] * U_SCALE, hv[2] * g[2] * U_SCALE, hv[3] * g[3] * U_SCALE); \
            _Pragma("unroll") for (int i = 0; i < 4; ++i) { acc0 = __builtin_amdgcn_mfma_f32_16x16x4f32(hv[i], b0[i], acc0, 0, 0, 0); acc1 = __builtin_amdgcn_mfma_f32_16x16x4f32(hv[i], b1[i], acc1, 0, 0, 0); } } } while (0)
    if (wave < 4) RT_HLOAD(hA, 0);
#pragma unroll 1
    for (int ch = 0; ch < 8; ch += 2) {
        asm volatile("s_waitcnt vmcnt(0)" ::: "memory");
        __syncthreads();
        RT_STAGE(ch + 1);
        if (wave < 4) { RT_HLOAD(hB, ch + 1); RT_COMPUTE(hA, ch); }
        asm volatile("s_waitcnt vmcnt(0)" ::: "memory");
        __syncthreads();
        if (ch + 2 < 8) RT_STAGE(ch + 2);
        if (wave < 4) { if (ch + 2 < 8) RT_HLOAD(hA, ch + 2); RT_COMPUTE(hB, ch + 1); }
    }
#undef RT_HLOAD
#undef RT_COMPUTE
#undef RT_STAGE
    if (wave < 4) {
        ssq += __shfl_xor(ssq, 16); ssq += __shfl_xor(ssq, 32);
        const float rs = rsqrtf(ssq * (1.0f / D) + 1e-5f);
        if (kq == 0) rstd[tok] = rs;
        const float be0 = br[qq], be1 = br[16 + qq];
#pragma unroll
        for (int r = 0; r < 4; ++r) {
            const float rr = __shfl(rs, 4 * kq + r);
            float v0 = acc0[r] * rr + be0, v1 = acc1[r] * rr + be1;
            float tv[4]; int ti[4];
#pragma unroll
            for (int k = 0; k < 4; ++k) {
                float bv = (v0 >= v1) ? v0 : v1; int bi = (v0 >= v1) ? qq : 16 + qq;
#pragma unroll
                for (int o = 1; o < 16; o <<= 1) { const float ov = __shfl_xor(bv, o); const int oi = __shfl_xor(bi, o); if (ov > bv || (ov == bv && oi < bi)) { bv = ov; bi = oi; } }
                tv[k] = bv; ti[k] = bi; if (bi == qq) v0 = -INFINITY; if (bi == 16 + qq) v1 = -INFINITY;
            }
            if (qq == 0) { const int row = task * 16 + 4 * kq + r;
                const float e1 = __expf(tv[1] - tv[0]), e2 = __expf(tv[2] - tv[0]), e3 = __expf(tv[3] - tv[0]); const float inv = 1.0f / (1.0f + e1 + e2 + e3);
                *(f32x4*)(gate + row * 4) = (f32x4){inv, e1 * inv, e2 * inv, e3 * inv};
                *(v4i_t*)(topi + row * 4) = (v4i_t){ti[0], ti[1], ti[2], ti[3]};
                if (count) { v4i_t lr;
#pragma unroll
                    for (int k = 0; k < 4; ++k) lr[k] = __hip_atomic_fetch_add(lh + ti[k], 1, __ATOMIC_RELAXED, __HIP_MEMORY_SCOPE_WORKGROUP);
                    *(v4i_t*)(lrank + row * 4) = lr; } }
        }
    }
    __syncthreads();
    if (count && tid < 32) cnt[wg * 32 + tid] = lh[tid];
}
__device__ __forceinline__ void place_scatter_phase(LAS unsigned char* lds, const int* cnt, const int* topi, const int* lrank, const float* rstd, int* rowtok,
                                                    float* rowscale, int* dest, unsigned* ctl, int wg, int G) {
    const int tid = tid_opaque(), wave = __builtin_amdgcn_readfirstlane(tid >> 6), lane = tid & 63;
    LAS int* sa = (LAS int*)lds;
    {   const int e = tid & 31, part = tid >> 5; int s_all = 0, s_bef = 0;
#pragma unroll
        for (int w2 = part * 16; w2 < part * 16 + 16; ++w2) { const int c = cnt[w2 * 32 + e]; s_all += c; s_bef += (w2 < wg) ? c : 0; }
        sa[part * 32 + e] = s_all; sa[512 + part * 32 + e] = s_bef; }
    __syncthreads();
    if (tid < 32) { int t = 0, b = 0;
#pragma unroll
        for (int part = 0; part < 16; ++part) { t += sa[part * 32 + tid]; b += sa[512 + part * 32 + tid]; }
        sa[1024 + tid] = t; sa[1056 + tid] = b; }
    __syncthreads();
    if (tid == 0) { int acc = 0; for (int e = 0; e < NE; ++e) { sa[1088 + e] = acc; const int nb = (sa[1024 + e] + 255) / 256;
            if (wg == 0) { for (int b = 0; b < nb; ++b) ctl[CW_BLKE + acc / 256 + b] = (unsigned)e; }
            acc += nb * 256; }
        if (wg == 0) ctl[CW_NBLK] = (unsigned)(acc / 256); }
    __syncthreads();
    if (tid < 256) { const int a = wg * 256 + tid, tok = a >> 2, e = topi[a], d = sa[1088 + e] + sa[1056 + e] + lrank[a];
        dest[a] = d; rowtok[d] = tok; rowscale[d] = rstd[tok]; }
    {   const int e = wg & 31, first = sa[1088 + e] + sa[1024 + e], last = sa[1088 + e] + ((sa[1024 + e] + 255) / 256) * 256;
        for (int row = first + (wg >> 5) * 512 + tid; row < last; row += (G >> 5) * 512) { rowtok[row] = T; rowscale[row] = 0.f; } }
}
__device__ __forceinline__ void combine_phase(const bf16_t* h, const unsigned char* y, const int* dest, const float* gate, float* out, int wg, int G) {
    const int tid = tid_opaque(), wave = tid >> 6, lane = tid & 63;
    for (int row = wg * NWAVES + wave; row < T; row += G * NWAVES) {
        int d[4]; float g[4];
#pragma unroll
        for (int k = 0; k < 4; ++k) { d[k] = dest[row * 4 + k]; g[k] = gate[row * 4 + k]; }
#pragma unroll
        for (int j = 0; j < 4; ++j) {
            const int c = (64 * j + lane) * 8;
            const u32x4 hw = *(const u32x4*)(h + (size_t)row * D + c);
            float o[8]; unpack8(hw, o);
#pragma unroll
            for (int k = 0; k < 4; ++k) { const u32x2 w = *(const u32x2*)(y + (size_t)d[k] * D + c); const float gk = g[k] * (1.0f / Y_SCALE);
                const pg8::f32v2_t p0 = __builtin_amdgcn_cvt_pk_f32_fp8((int)w.x, false), p1 = __builtin_amdgcn_cvt_pk_f32_fp8((int)w.x, true), p2 = __builtin_amdgcn_cvt_pk_f32_fp8((int)w.y, false), p3 = __builtin_amdgcn_cvt_pk_f32_fp8((int)w.y, true);
                o[0] += gk * p0[0]; o[1] += gk * p0[1]; o[2] += gk * p1[0]; o[3] += gk * p1[1]; o[4] += gk * p2[0]; o[5] += gk * p2[1]; o[6] += gk * p3[0]; o[7] += gk * p3[1]; }
            __builtin_nontemporal_store(((f32x4){o[0], o[1], o[2], o[3]}), (f32x4*)(out + (size_t)row * D + c)); __builtin_nontemporal_store(((f32x4){o[4], o[5], o[6], o[7]}), (f32x4*)(out + (size_t)row * D + c + 4));
        }
    }
}

__global__ void __launch_bounds__(512, 2) mega_fwd(Ptrs p) {
    extern __shared__ __attribute__((aligned(16))) unsigned char lds_raw[];
    LAS unsigned char* lds = (LAS unsigned char*)lds_raw;
    const int tid = tid_opaque(), wg = (int)blockIdx.x, G = (int)gridDim.x;
    unsigned char* ws = p.ws;
    unsigned* ctl = (unsigned*)(ws + WS_CTL);
    bf16_t *winT = (bf16_t*)(ws + WS_WINT), *woutT = (bf16_t*)(ws + WS_WOUTT); unsigned char *wguT = ws + WS_WGUT, *wdT = ws + WS_WDT;
    bf16_t *xn = (bf16_t*)(ws + WS_XN), *proj = (bf16_t*)(ws + WS_PROJ), *mixed = (bf16_t*)(ws + WS_MIXED);
    unsigned char *u = ws + WS_U, *xg = ws + WS_XG, *act = ws + WS_ACT, *y = ws + WS_Y;
    float *beta = (float*)(ws + WS_BETA), *gdec = (float*)(ws + WS_GDEC), *gate = (float*)(ws + WS_GATE); bf16_t* h = (bf16_t*)(ws + WS_H);
    int *topi = (int*)(ws + WS_TOPI), *dest = (int*)(ws + WS_DEST), *lrank = (int*)(ws + WS_LRANK), *cnt = (int*)(ws + WS_CNT); float* rowscale = (float*)(ws + WS_ROWTOK);
    int* rowtok = (int*)(ws + WS_RTOK);
    float *WB = (float*)(ws + WS_WB), *rstd = (float*)(ws + WS_RSTD), *xsc = (float*)(ws + WS_XS), *wsc = (float*)(ws + WS_WSC);
    bf16_t *NEGW = (bf16_t*)(ws + WS_NEGW), *QG = (bf16_t*)(ws + WS_QG), *KDT = (bf16_t*)(ws + WS_KDT), *UT = (bf16_t*)(ws + WS_UT), *AM = (bf16_t*)(ws + WS_AM); float* GLAST = (float*)(ws + WS_GLAST);

    if (tid < 4) ((LAS unsigned*)(lds + XB_OFF))[tid] = 0u;
    __syncthreads();
    XcdBarrier bar = xcd_barrier_post(ctl, (volatile LAS unsigned*)(lds + XB_OFF));

    {
    win8_phase(lds, p.w_in, (unsigned char*)winT, wsc, D, INW, INP, wg, G);
    wT_phase<0>(lds, p.w_out, woutT, D, D, D, 1, wg, G);
    rms8_phase(p.x, p.attn_norm_w, (unsigned char*)xn, xsc, 1e-5f, wg, G);
    wb_phase(p.ffn_norm_w, p.w_router, WB, wg, G);
    wT8_phase<1>(lds, p.w_gate_up, wguT, D, 4096, NE, ctl + CW_TILEQ);
    wT8_phase<0>(lds, p.w_down, wdT, FF, D, NE, ctl + CW_TILEQ + 64, 0, WD_EARLY);
    xcd_barrier(bar); }
    {   pg8::Gemm g{xn, winT, 0, D, 0}; pg8::EpiInProj E{proj, beta, gdec, p.a_log, p.dt_bias, xsc, wsc};
        pg8::StaticOrder S; S.init(T / 256, INP / 256, G, wg);
        pg8::gemm_phase<pg8::EpiInProj, pg8::StaticOrder, true, false, true>(lds, g, S, E);
    xcd_barrier(bar); }
    {
    constexpr int NSPLIT = 20, ATT1 = 192, NSCAN = BATCH * 8;
#pragma unroll 1
    for (int part = 0; part < 2; ++part) {
        if (part == 1 && wg < NSCAN) break;
        gdn::prep_phase(lds, proj, beta, gdec, p.conv_w, NEGW, QG, KDT, AM, UT, GLAST, part ? NSPLIT : 0, part ? 32 - NSPLIT : NSPLIT, part ? wg - NSCAN : wg, part ? G - NSCAN : G);
        if (part == 0) xcd_barrier(bar);
    }
    if (wg < NSCAN) gdn::scan_phase(lds, NEGW, QG, KDT, AM, UT, GLAST, proj, p.dn_norm_w, mixed, wg, NSPLIT, [&]() { xcd_barrier(bar); });
    else {
#pragma unroll 1
        for (int part = 0; part < 2; ++part) {
            att::attn_phase(lds, proj, p.q_norm_w, p.k_norm_w, p.sinks, mixed, part ? ATT1 : 0, part ? att::NITEMS : ATT1, wg - NSCAN, G - NSCAN);
            if (part == 0) xcd_barrier(bar);
        }
        wT8_phase<0>(lds, p.w_down, wdT, FF, D, NE, ctl + CW_TILEQ + 128, WD_EARLY, WD_TILES);
    }
    xcd_barrier(bar); }
    {   pg8::Gemm g{mixed, woutT, 0, D, 0}; pg8::EpiOutProj E{p.x, h};
        pg8::StaticOrder S; S.init(T / 256, D / 256, G, wg);
        pg8::gemm_phase<pg8::EpiOutProj, pg8::StaticOrder, true>(lds, g, S, E);
    xcd_barrier(bar); }
    {
    router_phase(lds, h, p.ffn_norm_w, WB, p.b_router, u, rstd, topi, gate, lrank, cnt, wg, G, true);
    xcd_barrier(bar); }
    {
    place_scatter_phase(lds, cnt, topi, lrank, rstd, rowtok, rowscale, dest, ctl, wg, G);
    xcd_barrier(bar); }
    {   pg8::Gemm g{u, wguT, (size_t)4096 * D, D, 0}; pg8::EpiSwiGLU E{act, p.b_gate_up, rowscale};
        pg8::MoeOrder S; S.init((int)xb_ld(&ctl[CW_NBLK]), 4096 / 256, G, wg); S.blke = (const int*)(ctl + CW_BLKE); S.rowtok = rowtok;
        pg8::gemm_phase<pg8::EpiSwiGLU, pg8::MoeOrder, true, true, false, true>(lds, g, S, E);
    xcd_barrier(bar); }
    {   pg8::Gemm g{act, wdT, (size_t)D * FF, FF, 0}; pg8::EpiDown E{y, p.b_down};
        pg8::MoeOrder S; S.init((int)xb_ld(&ctl[CW_NBLK]), D / 256, G, wg); S.blke = (const int*)(ctl + CW_BLKE); S.rowtok = rowtok;
        pg8::gemm_phase<pg8::EpiDown, pg8::MoeOrder, true, true>(lds, g, S, E);
    xcd_barrier(bar); }
    combine_phase(h, y, dest, gate, p.out, wg, G);
}

extern "C" void kernel_launch(void* const* d_in, const int* in_sizes, int n_in, void* d_out, int out_size, void* d_ws, size_t ws_size, hipStream_t stream) {
    static int grid = 0;
    if (grid == 0) {
        if (n_in != 18 || in_sizes[0] != T * D || out_size != T * D || ws_size < WS_END) { fprintf(stderr, "kernel_launch: unexpected shapes (n_in %d, in0 %d, out %d, ws %zu < %zu)\n", n_in, n_in > 0 ? in_sizes[0] : -1, out_size, ws_size, (size_t)WS_END); grid = -1; return; }
        int dev = 0, cus = 0, per_cu = 0;
        if (hipGetDevice(&dev) != hipSuccess || hipDeviceGetAttribute(&cus, hipDeviceAttributeMultiprocessorCount, dev) != hipSuccess) { grid = -1; return; }
        if (hipFuncSetAttribute((const void*)mega_fwd, hipFuncAttributeMaxDynamicSharedMemorySize, LDS_BYTES) != hipSuccess) { fprintf(stderr, "kernel_launch: hipFuncSetAttribute failed\n"); grid = -1; return; }
        if (hipOccupancyMaxActiveBlocksPerMultiprocessor(&per_cu, (const void*)mega_fwd, 512, LDS_BYTES) != hipSuccess || per_cu < 1) { fprintf(stderr, "kernel_launch: occupancy query says %d\n", per_cu); grid = -1; (void)hipGetLastError(); return; }
        grid = cus;
        if (grid != 256 || T != 64 * grid) { fprintf(stderr, "kernel_launch: built for a 256-CU device (got %d)\n", grid); grid = -1; return; }
    }
    if (grid < 0) return;
    Ptrs p{};
    const float** pf = (const float**)&p;
    for (int i = 0; i < 18; ++i) pf[i] = (const float*)d_in[i];
    p.out = (float*)d_out; p.ws = (unsigned char*)d_ws;
    (void)hipMemsetAsync((unsigned char*)d_ws + WS_CTL, 0, 128u << 10, stream);
    hipLaunchKernelGGL(mega_fwd, dim3(grid), dim3(512), LDS_BYTES, stream, p);
}
```
